# Optimizing an MI355X kernel written in HIP

```python
import math
import jax, jax.numpy as jnp
from jax import lax
import numpy as np

D_MODEL = 1024
BATCH = 16
SEQ = 2048
DEPTH = 4

N_MIXERS = 2
N_HEADS = 16
HEAD_DIM = D_MODEL // N_HEADS
D_ATTN = N_HEADS * HEAD_DIM
DILATED_GROUPS = ((128, 1), (512, 4), (2048, 16))
N_GROUPS = len(DILATED_GROUPS)
BLOCK = 128
D_FF = 7 * D_MODEL // 2
N_EXPERTS = 8
TOP_K = 2
RMS_EPS = 1e-6

kernel_name = 'hybrid_dilated_stickbreaking_moe'


def rmsnorm(x, g):
    xf = x.astype(jnp.float32)
    y = xf * lax.rsqrt(jnp.mean(xf * xf, axis=-1, keepdims=True) + RMS_EPS)
    return (y * g.astype(jnp.float32)).astype(x.dtype)


def alibi_slopes(n):
    return jnp.asarray(2.0 ** (-8.0 * np.arange(1, n + 1) / n), dtype=jnp.float32)


def dilated_window_branch(q, k, v, window, dilation, slopes):
    b, s, h, dh = q.shape
    span = window // dilation
    n_prev = -(-span // BLOCK)
    sub_len = s // dilation
    nb = -(-sub_len // BLOCK)
    sub_pad = nb * BLOCK

    def to_sub(t):
        t = t.reshape(b, sub_len, dilation, h, dh).transpose(0, 2, 1, 3, 4)
        t = jnp.pad(t, ((0, 0), (0, 0), (0, sub_pad - sub_len), (0, 0), (0, 0)))
        return t.reshape(b, dilation, nb, BLOCK, h, dh)

    def band(t):
        tp = jnp.pad(t, ((0, 0), (0, 0), (n_prev, 0), (0, 0), (0, 0), (0, 0)))
        return jnp.concatenate([tp[:, :, i:i + nb] for i in range(n_prev + 1)], axis=3)

    qb = to_sub(q)
    kband = band(to_sub(k))
    vband = band(to_sub(v)).astype(jnp.float32)
    nk = (n_prev + 1) * BLOCK

    a = jnp.arange(BLOCK)[:, None]
    m = jnp.arange(nk)[None, :]
    rel = n_prev * BLOCK + a - m
    kpos = (jnp.arange(nb) * BLOCK)[:, None, None] + (a - rel)[None]
    valid = ((rel >= 0) & (rel <= span))[None] & (kpos >= 0)
    bias = -slopes[:, None, None] * (rel * dilation).astype(jnp.float32)[None]

    scores = jnp.einsum('brnqhd,brnkhd->brnhqk', qb, kband,
                        preferred_element_type=jnp.float32) * (1.0 / math.sqrt(dh))
    scores = jnp.where(valid[None, None, :, None], scores + bias, -jnp.inf)
    s_max = jnp.max(scores, axis=-1, keepdims=True)
    p = jnp.exp(scores - s_max)
    z = jnp.sum(p, axis=-1)
    out = jnp.einsum('brnhqk,brnkhd->brnqhd', p, vband)
    z_q = z.transpose(0, 1, 2, 4, 3)
    out = out / z_q[..., None]
    lse = s_max[..., 0].transpose(0, 1, 2, 4, 3) + jnp.log(z_q)

    out = out.reshape(b, dilation, sub_pad, h, dh)[:, :, :sub_len]
    out = out.transpose(0, 2, 1, 3, 4).reshape(b, s, h, dh)
    lse = lse.reshape(b, dilation, sub_pad, h)[:, :, :sub_len]
    lse = lse.transpose(0, 2, 1, 3).reshape(b, s, h)
    return out, lse


def dilated_mixer(hn, w_in, w_out, slopes):
    b, s, _ = hn.shape
    proj = (hn @ w_in).reshape(b, s, N_GROUPS, 3, N_HEADS, HEAD_DIM)
    outs, lses = [], []
    for g, (window, dilation) in enumerate(DILATED_GROUPS):
        o, l = dilated_window_branch(proj[:, :, g, 0], proj[:, :, g, 1], proj[:, :, g, 2],
                                     window, dilation, slopes)
        outs.append(o)
        lses.append(l)
    wts = jax.nn.softmax(jnp.stack(lses, axis=0), axis=0)
    y = jnp.sum(wts[..., None] * jnp.stack(outs, axis=0), axis=0)
    return y.reshape(b, s, D_ATTN).astype(hn.dtype) @ w_out


def stick_breaking_mixer(hn, w_qkv, w_out):
    b, s, _ = hn.shape
    qkv = (hn @ w_qkv).reshape(b, s, 3, N_HEADS, HEAD_DIM)
    q, k, v = qkv[:, :, 0], qkv[:, :, 1], qkv[:, :, 2]
    scale = 1.0 / math.sqrt(HEAD_DIM)
    outs = []
    for blk in range(s // BLOCK):
        start = blk * BLOCK
        end = start + BLOCK
        z = jnp.einsum('bqhd,bkhd->bhqk', q[:, start:end], k[:, :end],
                       preferred_element_type=jnp.float32) * scale
        t_idx = start + jnp.arange(BLOCK)[:, None]
        s_idx = jnp.arange(end)[None, :]
        strict = s_idx < t_idx
        log_beta = jax.nn.log_sigmoid(z)
        log_1mb = jnp.where(strict, jax.nn.log_sigmoid(-z), 0.0)
        after = lax.cumsum(log_1mb, axis=3, reverse=True) - log_1mb
        att = jnp.where(strict, jnp.exp(log_beta + after), 0.0)
        outs.append(jnp.einsum('bhqk,bkhd->bqhd', att, v[:, :end].astype(jnp.float32)))
    y = jnp.concatenate(outs, axis=1)
    return y.reshape(b, s, D_ATTN).astype(hn.dtype) @ w_out


def swiglu(hn, w_gate_up, w_down):
    g, u = jnp.split(hn @ w_gate_up, 2, axis=-1)
    return (jax.nn.silu(g) * u) @ w_down


def moe_swiglu(hn, w_router, w_gate_up, w_down):
    logits = jnp.einsum('bsd,de->bse', hn, w_router, preferred_element_type=jnp.float32)
    top_val, top_idx = lax.top_k(logits, TOP_K)
    top_w = jax.nn.softmax(top_val, axis=-1)
    gates = jnp.sum(jax.nn.one_hot(top_idx, N_EXPERTS, dtype=jnp.float32) * top_w[..., None], axis=-2)
    y = jnp.zeros_like(hn)
    for e in range(N_EXPERTS):
        y = y + gates[..., e:e + 1].astype(hn.dtype) * swiglu(hn, w_gate_up[e], w_down[e])
    return y


def setup_inputs(seed: int = 0) -> dict:
    key = jax.random.key(seed)
    ks = jax.random.split(key, 14)
    n_a = (DEPTH + 1) // 2
    n_b = DEPTH // 2

    def w(k, shape, fan_in):
        return jax.random.normal(k, shape, jnp.float32) * (fan_in ** -0.5)

    return {
        'x': jax.random.normal(ks[0], (BATCH, SEQ, D_MODEL), jnp.float32),
        'mix_norm': 1.0 + 0.02 * jax.random.normal(ks[1], (DEPTH, D_MODEL), jnp.float32),
        'ffn_norm': 1.0 + 0.02 * jax.random.normal(ks[2], (DEPTH, D_MODEL), jnp.float32),
        'dil_w_in': w(ks[3], (n_a, D_MODEL, N_GROUPS * 3 * D_ATTN), D_MODEL),
        'dil_w_out': w(ks[4], (n_a, D_ATTN, D_MODEL), D_ATTN),
        'sb_w_qkv': w(ks[5], (n_b, D_MODEL, 3 * D_ATTN), D_MODEL),
        'sb_w_out': w(ks[6], (n_b, D_ATTN, D_MODEL), D_ATTN),
        'ffn_w_gate_up': w(ks[7], (n_a, D_MODEL, 2 * D_FF), D_MODEL),
        'ffn_w_down': w(ks[8], (n_a, D_FF, D_MODEL), D_FF),
        'moe_w_router': w(ks[9], (n_b, D_MODEL, N_EXPERTS), D_MODEL),
        'moe_w_gate_up': w(ks[10], (n_b, N_EXPERTS, D_MODEL, 2 * D_FF), D_MODEL),
        'moe_w_down': w(ks[11], (n_b, N_EXPERTS, D_FF, D_MODEL), D_FF),
        'final_norm': 1.0 + 0.02 * jax.random.normal(ks[12], (D_MODEL,), jnp.float32),
    }


def reference(x, mix_norm, ffn_norm, dil_w_in, dil_w_out, sb_w_qkv, sb_w_out,
              ffn_w_gate_up, ffn_w_down, moe_w_router, moe_w_gate_up, moe_w_down, final_norm):
    slopes = alibi_slopes(N_HEADS)
    h = x
    for i in range(DEPTH):
        j = i // 2
        hn = rmsnorm(h, mix_norm[i])
        if i % N_MIXERS == 0:
            h = h + dilated_mixer(hn, dil_w_in[j], dil_w_out[j], slopes)
        else:
            h = h + stick_breaking_mixer(hn, sb_w_qkv[j], sb_w_out[j])
        hn = rmsnorm(h, ffn_norm[i])
        if i % 2 == 0:
            h = h + swiglu(hn, ffn_w_gate_up[j], ffn_w_down[j])
        else:
            h = h + moe_swiglu(hn, moe_w_router[j], moe_w_gate_up[j], moe_w_down[j])
    return rmsnorm(h, final_norm)
```

```cpp
#include <hip/hip_runtime.h>
#include <cstdio>
#include <cstdint>
namespace pg8 {
#define PG8_LAS __attribute__((address_space(3)))
typedef unsigned short bf16_t;
typedef short bf16x8 __attribute__((ext_vector_type(8)));
typedef float f32x4 __attribute__((ext_vector_type(4)));
typedef unsigned u32x4 __attribute__((ext_vector_type(4)));
constexpr int BM = 256, BK = 64, HALF = 128, HTB = HALF * BK * 2  , STAGE_BYTES = 8 * HTB, NXCD = 8, WGM = 8;

__host__ __device__ __forceinline__ int lds_byte(int r, int c) { const int st = (r >> 4) * 2 + (c >> 5), rr = r & 15, cc = c & 31, ob = rr * 64 + cc * 2; return st * 1024 + (ob ^ (((ob >> 9) & 1) << 5)); }
__host__ __device__ __forceinline__ void stage_rc(int b, int& R, int& C) { const int st = b / 1024, sb = b % 1024, swz = sb ^ (((sb >> 9) & 1) << 5); R = (st >> 1) * 16 + swz / 64; C = (st & 1) * 32 + (swz % 64) / 2; }
__host__ __device__ __forceinline__ int perm32(int rho) { const int n = rho >> 4, i = rho & 15; return 8 * (i >> 2) + 4 * n + (i & 3); }

struct Unit { int pm, pn, pb; };
struct Gemm { const bf16_t* A; const bf16_t* Bt; int M, N, K; };

struct StaticOrder {
    int nM, nN, nwg, G, c; const unsigned* pexp;
    __device__ void init(int M, int N, int G_, int c_, const unsigned* pexp_ = nullptr) { nM = M / BM; nN = N / BM; nwg = nM * nN; G = G_; c = c_; pexp = pexp_; }
    __device__ bool next(int i, Unit& u) const {
        const long L = (long)i * G + c; if (L >= nwg) return false;
        int wgid = (int)L; { const int q = nwg / NXCD, r = nwg % NXCD, xcd = wgid % NXCD, off = wgid / NXCD; wgid = (xcd < r ? xcd * (q + 1) : r * (q + 1) + (xcd - r) * q) + off; }
        const int nig = WGM * nN, gid = wgid / nig, fm = gid * WGM, gsz = (nM - fm) < WGM ? (nM - fm) : WGM;
        u.pm = fm + ((wgid % nig) % gsz); u.pn = (wgid % nig) / gsz;
        u.pb = pexp ? (int)__builtin_amdgcn_readfirstlane(__hip_atomic_load(pexp + u.pm, __ATOMIC_RELAXED, __HIP_MEMORY_SCOPE_AGENT)) * nN + u.pn : u.pn; return true;
    }
    __device__ __forceinline__ void a_ready(const Unit&) const {}
    __device__ __forceinline__ void done(const Unit&) const {}
};


__device__ __forceinline__ unsigned cvt_pk_bf16(float lo, float hi) { unsigned r; asm volatile("v_cvt_pk_bf16_f32 %0, %1, %2" : "=v"(r) : "v"(lo), "v"(hi)); return r; }
template <class Epi, class Sched, bool ALIGN_EPI = false, bool SP2 = false>
__device__ __forceinline__ void gemm_phase(PG8_LAS unsigned char* lds, const Gemm g, const Sched& S, const Epi& E) {
    int tid_ = threadIdx.x; asm volatile("" : "+v"(tid_));
    const int tid = tid_, wid = __builtin_amdgcn_readfirstlane(tid >> 6), lane = tid & 63, wr = wid >> 2, wc = wid & 3, fr = lane & 15, fq = lane >> 4;
    const int K = g.K, nt = K / BK;
    unsigned voffA[2], voffB[2];
#pragma unroll
    for (int i = 0; i < 2; ++i) { int R, C; stage_rc(tid * 16 + i * 8192, R, C); const int Rb = Epi::PERM ? ((R & ~31) + perm32(R & 31)) : R;
        voffA[i] = (unsigned)(R * K + C) * 2u; voffB[i] = (unsigned)(Rb * K + C) * 2u; }
    const size_t kstep = (size_t)(BK * 2);
    const size_t hstep = (size_t)HALF * K * 2;
    const size_t tstep = 2 * hstep;
    const unsigned ldsw = (unsigned)wid * 1024u;
    const int aoff = lds_byte(wr * 64 + fr, fq * 8), boff = lds_byte(wc * 32 + fr, fq * 8);
#define PG8_SA(b, h) (((b) * 2 + (h)) * HTB)
#define PG8_SB(b, h) ((4 + (b) * 2 + (h)) * HTB)
#define PG8_STAGE(bufoff, gbase, voff) do { _Pragma("unroll") for (int _i = 0; _i < 2; ++_i) \
        __builtin_amdgcn_global_load_lds((const unsigned*)((const char*)(gbase) + (voff)[_i]), (PG8_LAS unsigned*)(lds + (bufoff) + ldsw + _i * 8192), 16, 0, 0); } while (0)
#define PG8_LDA(dst, b, h) do { _Pragma("unroll") for (int m = 0; m < 4; ++m) _Pragma("unroll") for (int k = 0; k < 2; ++k) dst[m][k] = *(const PG8_LAS bf16x8*)(lds + PG8_SA(b, h) + aoff + m * 2048 + k * 1024); } while (0)
#define PG8_LDB(dst, b, h) do { _Pragma("unroll") for (int n = 0; n < 2; ++n) _Pragma("unroll") for (int k = 0; k < 2; ++k) dst[n][k] = *(const PG8_LAS bf16x8*)(lds + PG8_SB(b, h) + boff + n * 2048 + k * 1024); } while (0)
#define PG8_MMA(ai, bj, At, Bt) do { __builtin_amdgcn_s_setprio(1); _Pragma("unroll") for (int m = 0; m < 4; ++m) _Pragma("unroll") for (int n = 0; n < 2; ++n) _Pragma("unroll") for (int k = 0; k < 2; ++k) \
        acc[ai][bj][m][n] = __builtin_amdgcn_mfma_f32_16x16x32_bf16(Bt[n][k], At[m][k], acc[ai][bj][m][n], 0, 0, 0); __builtin_amdgcn_s_setprio(0); } while (0)
#define PG8_WAIT_V(n) asm volatile("s_waitcnt vmcnt(" #n ")" ::: "memory")
#define PG8_WAIT_L(n) asm volatile("s_waitcnt lgkmcnt(" #n ")" ::: "memory")
#define PG8_BAR __builtin_amdgcn_s_barrier()
#define PG8_SCHED __builtin_amdgcn_sched_barrier(0)
    Unit cur, nxt; int ui = 0;
    if (!S.next(0, cur)) return;
    f32x4 acc[2][2][4][2];
#pragma unroll
    for (int a = 0; a < 2; ++a)
#pragma unroll
        for (int b = 0; b < 2; ++b)
#pragma unroll
            for (int m = 0; m < 4; ++m)
#pragma unroll
                for (int n = 0; n < 2; ++n) acc[a][b][m][n] = (f32x4){0.f, 0.f, 0.f, 0.f};
    bf16x8 At[4][2], B0[2][2], B1[2][2];
    const char* cA = (const char*)g.A + (size_t)cur.pm * tstep; const char* cB = (const char*)g.Bt + (size_t)cur.pb * tstep;
    S.a_ready(cur);
    if constexpr (SP2) {
        PG8_STAGE(PG8_SB(0, 0), cB, voffB); PG8_STAGE(PG8_SB(0, 1), cB + hstep, voffB); PG8_STAGE(PG8_SA(0, 0), cA, voffA); PG8_STAGE(PG8_SA(0, 1), cA + hstep, voffA);
        if (wr == 1) PG8_BAR;
        PG8_WAIT_V(2); PG8_BAR;
        PG8_STAGE(PG8_SB(1, 0), cB + kstep, voffB); PG8_STAGE(PG8_SA(1, 0), cA + kstep, voffA); PG8_STAGE(PG8_SB(1, 1), cB + hstep + kstep, voffB);
        PG8_WAIT_V(6); PG8_BAR;
    } else {
        PG8_STAGE(PG8_SB(0, 0), cB, voffB); PG8_STAGE(PG8_SA(0, 0), cA, voffA); PG8_STAGE(PG8_SB(0, 1), cB + hstep, voffB); PG8_STAGE(PG8_SA(0, 1), cA + hstep, voffA);
        if (wr == 1) PG8_BAR;
        PG8_WAIT_V(4); PG8_BAR;
        PG8_STAGE(PG8_SB(1, 0), cB + kstep, voffB); PG8_STAGE(PG8_SA(1, 0), cA + kstep, voffA); PG8_STAGE(PG8_SB(1, 1), cB + hstep + kstep, voffB);
        PG8_WAIT_V(6); PG8_BAR;
    }
    for (;;) {
        const bool has_next = S.next(ui + 1, nxt);
        const char* nA = has_next ? (const char*)g.A + (size_t)nxt.pm * tstep : cA; const char* nB = has_next ? (const char*)g.Bt + (size_t)nxt.pb * tstep : cB;
        for (int t = 0; t < nt; t += 2) {
            const bool last = (t == nt - 2);
            const char* a1 = cA + (size_t)(t + 1) * kstep;
            const char* a2 = last ? nA : cA + (size_t)(t + 2) * kstep; const char* b2 = last ? nB : cB + (size_t)(t + 2) * kstep;
            const char* a3 = a2 + kstep; const char* b3 = b2 + kstep;
            if (last && has_next) S.a_ready(nxt);
            if constexpr (SP2) {
            PG8_LDB(B0, 0, 0); PG8_LDB(B1, 0, 1); PG8_SCHED; PG8_LDA(At, 0, 0); PG8_STAGE(PG8_SA(1, 1), a1 + hstep, voffA);
            PG8_WAIT_V(8); PG8_WAIT_L(0); PG8_BAR; PG8_MMA(0, 0, At, B0); PG8_MMA(0, 1, At, B1); PG8_BAR; PG8_SCHED;
            PG8_LDA(At, 0, 1); PG8_STAGE(PG8_SB(0, 0), b2, voffB); PG8_STAGE(PG8_SB(0, 1), b2 + hstep, voffB); PG8_STAGE(PG8_SA(0, 0), a2, voffA);
            PG8_WAIT_V(8); PG8_WAIT_L(0); PG8_BAR; PG8_MMA(1, 0, At, B0); PG8_MMA(1, 1, At, B1); PG8_BAR; PG8_SCHED;
            PG8_LDB(B0, 1, 0); PG8_LDB(B1, 1, 1); PG8_SCHED; PG8_LDA(At, 1, 0); PG8_STAGE(PG8_SA(0, 1), a2 + hstep, voffA);
            PG8_WAIT_V(8); PG8_WAIT_L(0); PG8_BAR; PG8_MMA(0, 0, At, B0); PG8_MMA(0, 1, At, B1); PG8_BAR; PG8_SCHED;
            PG8_LDA(At, 1, 1); PG8_STAGE(PG8_SB(1, 0), b3, voffB); PG8_STAGE(PG8_SB(1, 1), b3 + hstep, voffB); PG8_STAGE(PG8_SA(1, 0), a3, voffA);
            PG8_WAIT_V(8); PG8_WAIT_L(0); PG8_BAR; PG8_MMA(1, 0, At, B0); PG8_MMA(1, 1, At, B1); PG8_BAR; PG8_SCHED;
            } else {
            PG8_LDB(B0, 0, 0); PG8_SCHED; PG8_LDA(At, 0, 0); PG8_STAGE(PG8_SA(1, 1), a1 + hstep, voffA);
            PG8_WAIT_L(8); PG8_BAR; PG8_WAIT_L(0); PG8_MMA(0, 0, At, B0); PG8_BAR; PG8_SCHED;
            PG8_LDB(B1, 0, 1); PG8_STAGE(PG8_SB(0, 0), b2, voffB);
            PG8_BAR; PG8_WAIT_L(0); PG8_MMA(0, 1, At, B1); PG8_BAR;
            PG8_LDA(At, 0, 1); PG8_STAGE(PG8_SA(0, 0), a2, voffA);
            PG8_BAR; PG8_WAIT_L(0); PG8_MMA(1, 0, At, B0); PG8_BAR; PG8_SCHED;
            PG8_STAGE(PG8_SB(0, 1), b2 + hstep, voffB);
            PG8_WAIT_V(6); PG8_BAR; PG8_MMA(1, 1, At, B1); PG8_BAR;
            PG8_LDB(B0, 1, 0); PG8_SCHED; PG8_LDA(At, 1, 0); PG8_STAGE(PG8_SA(0, 1), a2 + hstep, voffA);
            PG8_WAIT_L(8); PG8_BAR; PG8_WAIT_L(0); PG8_MMA(0, 0, At, B0); PG8_BAR; PG8_SCHED;
            PG8_LDB(B1, 1, 1); PG8_STAGE(PG8_SB(1, 0), b3, voffB);
            PG8_BAR; PG8_WAIT_L(0); PG8_MMA(0, 1, At, B1); PG8_BAR;
            PG8_LDA(At, 1, 1); PG8_STAGE(PG8_SA(1, 0), a3, voffA);
            PG8_BAR; PG8_WAIT_L(0); PG8_MMA(1, 0, At, B0); PG8_BAR; PG8_SCHED;
            PG8_STAGE(PG8_SB(1, 1), b3 + hstep, voffB);
            PG8_WAIT_V(6); PG8_BAR; PG8_MMA(1, 1, At, B1); PG8_BAR;
            }
        }
        if constexpr (ALIGN_EPI) { if (wr == 0) PG8_BAR; }
        if constexpr (!Epi::AFTER_DRAIN) { E(acc, cur, wr, wc, fr, fq); S.done(cur); }
        if (!has_next) break;
#pragma unroll
        for (int a = 0; a < 2; ++a)
#pragma unroll
            for (int b = 0; b < 2; ++b)
#pragma unroll
                for (int m = 0; m < 4; ++m)
#pragma unroll
                    for (int n = 0; n < 2; ++n) acc[a][b][m][n] = (f32x4){0.f, 0.f, 0.f, 0.f};
        cur = nxt; cA = nA; cB = nB; ++ui;
        if constexpr (ALIGN_EPI) { if (wr == 1) PG8_BAR; }
    }
    PG8_WAIT_V(0);
    if constexpr (!ALIGN_EPI) { if (wr == 0) PG8_BAR; }
    PG8_BAR;
    if constexpr (Epi::AFTER_DRAIN) { E.fused(acc, cur, wr, wc, fr, fq, lds, wid, lane); S.done(cur); }
#undef PG8_SA
#undef PG8_SB
#undef PG8_STAGE
#undef PG8_LDA
#undef PG8_LDB
#undef PG8_MMA
#undef PG8_WAIT_V
#undef PG8_WAIT_L
#undef PG8_BAR
#undef PG8_SCHED
}
}
namespace pg8 {
struct EpiStore {
    static constexpr bool PERM = true, AFTER_DRAIN = false;
    bf16_t* O; int ldc;
    __device__ __forceinline__ void operator()(const f32x4 (&acc)[2][2][4][2], const Unit& u, int wr, int wc, int fr, int fq) const {
        const int row0 = u.pm * BM + wr * 64 + fr, col0 = u.pn * BM + wc * 32 + 8 * fq;
#pragma unroll
        for (int ai = 0; ai < 2; ++ai)
#pragma unroll
            for (int m = 0; m < 4; ++m) { bf16_t* rowp = O + (size_t)(row0 + ai * HALF + m * 16) * ldc + col0;
#pragma unroll
                for (int bj = 0; bj < 2; ++bj) { const f32x4 v0 = acc[ai][bj][m][0], v1 = acc[ai][bj][m][1];
                    u32x4 w; w.x = cvt_pk_bf16(v0[0], v0[1]); w.y = cvt_pk_bf16(v0[2], v0[3]); w.z = cvt_pk_bf16(v1[0], v1[1]); w.w = cvt_pk_bf16(v1[2], v1[3]);
                    *(u32x4*)(rowp + bj * HALF) = w; } }
    }
};
struct EpiResid {
    static constexpr bool PERM = false, AFTER_DRAIN = false;
    float* H; int ldc;
    __device__ __forceinline__ void operator()(const f32x4 (&acc)[2][2][4][2], const Unit& u, int wr, int wc, int fr, int fq) const {
        const int col0 = u.pn * BM + wc * 32 + 4 * fq;
#pragma unroll
        for (int ai = 0; ai < 2; ++ai)
#pragma unroll
            for (int m = 0; m < 4; ++m) { float* rowp = H + (size_t)(u.pm * BM + ai * HALF + wr * 64 + m * 16 + fr) * ldc + col0;
#pragma unroll
                for (int bj = 0; bj < 2; ++bj)
#pragma unroll
                    for (int n = 0; n < 2; ++n) { f32x4* p = (f32x4*)(rowp + bj * HALF + n * 16); *p = *p + acc[ai][bj][m][n]; } }
    }
};
struct EpiSwiGLU {
    static constexpr bool PERM = true, AFTER_DRAIN = false;
    bf16_t* O; int ldc;
    static __device__ __forceinline__ float act(float g, float up) { return g * __builtin_amdgcn_rcpf(1.0f + __builtin_amdgcn_exp2f(-1.4426950408889634f * g)) * up; }
    __device__ __forceinline__ void operator()(const f32x4 (&acc)[2][2][4][2], const Unit& u, int wr, int wc, int fr, int fq) const {
        const int row0 = u.pm * BM + wr * 64 + fr, col0 = u.pn * HALF + wc * 32 + 8 * fq;
#pragma unroll
        for (int ai = 0; ai < 2; ++ai)
#pragma unroll
            for (int m = 0; m < 4; ++m) { bf16_t* rowp = O + (size_t)(row0 + ai * HALF + m * 16) * ldc + col0;
                const f32x4 g0 = acc[ai][0][m][0], g1 = acc[ai][0][m][1], u0 = acc[ai][1][m][0], u1 = acc[ai][1][m][1];
                u32x4 w; w.x = cvt_pk_bf16(act(g0[0], u0[0]), act(g0[1], u0[1])); w.y = cvt_pk_bf16(act(g0[2], u0[2]), act(g0[3], u0[3]));
                w.z = cvt_pk_bf16(act(g1[0], u1[0]), act(g1[1], u1[1])); w.w = cvt_pk_bf16(act(g1[2], u1[2]), act(g1[3], u1[3]));
                *(u32x4*)rowp = w; }
    }
};
struct EpiMoeDown {
    static constexpr bool PERM = true, AFTER_DRAIN = false;
    bf16_t* O; int ldc; const float* gate;
    __device__ __forceinline__ void operator()(const f32x4 (&acc)[2][2][4][2], const Unit& u, int wr, int wc, int fr, int fq) const {
        const int row0 = u.pm * BM + wr * 64 + fr, col0 = u.pn * BM + wc * 32 + 8 * fq;
#pragma unroll
        for (int ai = 0; ai < 2; ++ai)
#pragma unroll
            for (int m = 0; m < 4; ++m) { const int row = row0 + ai * HALF + m * 16; const float gt = gate[row]; bf16_t* rowp = O + (size_t)row * ldc + col0;
#pragma unroll
                for (int bj = 0; bj < 2; ++bj) { const f32x4 v0 = acc[ai][bj][m][0] * gt, v1 = acc[ai][bj][m][1] * gt;
                    u32x4 w; w.x = cvt_pk_bf16(v0[0], v0[1]); w.y = cvt_pk_bf16(v0[2], v0[3]); w.z = cvt_pk_bf16(v1[0], v1[1]); w.w = cvt_pk_bf16(v1[2], v1[3]);
                    *(u32x4*)(rowp + bj * HALF) = w; } }
    }
};
}
namespace att {
typedef float f32x16 __attribute__((ext_vector_type(16)));
typedef float f32x2v __attribute__((ext_vector_type(2)));
typedef __bf16 bf16x2v __attribute__((ext_vector_type(2)));
typedef short bf16x8 __attribute__((ext_vector_type(8)));
typedef unsigned u32x4 __attribute__((ext_vector_type(4)));
typedef unsigned u32x2 __attribute__((ext_vector_type(2)));
typedef unsigned short bf16;
#define ATT_LAS __attribute__((address_space(3)))
constexpr float LOG2E = 1.4426950408889634f, LN2 = 0.6931471805599453f;
constexpr int VT_STRIDE = 72;
constexpr int VT_BYTES = 64 * VT_STRIDE;
__device__ __forceinline__ int crow(int r, int hi) { return (r & 3) + 8 * (r >> 2) + 4 * hi; }
__device__ __forceinline__ unsigned cvtpk(float lo, float hi) { f32x2v v = {lo, hi}; bf16x2v b = __builtin_convertvector(v, bf16x2v); return __builtin_bit_cast(unsigned, b); }

__device__ __forceinline__ void load_rowfrags(bf16x8 (&f)[4], const bf16* rowbase  , int hh) {
#pragma unroll
    for (int ks = 0; ks < 4; ++ks) f[ks] = *(const bf16x8*)(rowbase + ks * 16 + hh * 8);
}
__device__ __forceinline__ f32x16 qk_tile(const bf16x8 (&kf)[4], const bf16x8 (&qf)[4]) {
    f32x16 s = {};
#pragma unroll
    for (int ks = 0; ks < 4; ++ks) s = __builtin_amdgcn_mfma_f32_32x32x16_bf16(kf[ks], qf[ks], s, 0, 0, 0);
    return s;
}
__device__ __forceinline__ void stage_vt(ATT_LAS unsigned char* vt, const bf16* vbase, size_t rowstride, int lane) {
    u32x4 v[4];
#pragma unroll
    for (int it = 0; it < 4; ++it) v[it] = *(const u32x4*)(vbase + (size_t)((lane >> 3) + 8 * it) * rowstride + (lane & 7) * 8);
#pragma unroll
    for (int it = 0; it < 4; ++it) { const int key = (lane >> 3) + 8 * it; ATT_LAS unsigned char* p = vt + ((lane & 7) * 8) * VT_STRIDE + key * 2;
#pragma unroll
        for (int e = 0; e < 8; ++e) { const unsigned w = v[it][e >> 1]; *(ATT_LAS unsigned short*)(p + e * VT_STRIDE) = (unsigned short)((e & 1) ? (w >> 16) : (w & 0xffffu)); } }
}
__device__ __forceinline__ void pv_tile(f32x16 (&o)[2], const f32x16& p, const ATT_LAS unsigned char* vt, int lane) {
    const int r32 = lane & 31, hh = lane >> 5;
    bf16x8 pb[2];
#pragma unroll
    for (int s = 0; s < 2; ++s) { u32x4 w; w.x = cvtpk(p[8 * s + 0], p[8 * s + 1]); w.y = cvtpk(p[8 * s + 2], p[8 * s + 3]); w.z = cvtpk(p[8 * s + 4], p[8 * s + 5]); w.w = cvtpk(p[8 * s + 6], p[8 * s + 7]); pb[s] = __builtin_bit_cast(bf16x8, w); }
#pragma unroll
    for (int db = 0; db < 2; ++db)
#pragma unroll
        for (int s = 0; s < 2; ++s) {
            const ATT_LAS unsigned char* rp = vt + (db * 32 + r32) * VT_STRIDE + (16 * s + 4 * hh) * 2;
            const u32x2 lo = *(const ATT_LAS u32x2*)rp, hi = *(const ATT_LAS u32x2*)(rp + 16);
            u32x4 a; a.x = lo.x; a.y = lo.y; a.z = hi.x; a.w = hi.y;
            o[db] = __builtin_amdgcn_mfma_f32_32x32x16_bf16(__builtin_bit_cast(bf16x8, a), pb[s], o[db], 0, 0, 0);
        }
}
__device__ __forceinline__ void store_ot(bf16* orow  , const f32x16 (&o)[2], float scale, int hh) {
#pragma unroll
    for (int db = 0; db < 2; ++db)
#pragma unroll
        for (int q = 0; q < 4; ++q) { u32x2 w; w.x = cvtpk(o[db][4 * q] * scale, o[db][4 * q + 1] * scale); w.y = cvtpk(o[db][4 * q + 2] * scale, o[db][4 * q + 3] * scale);
            *(u32x2*)(orow + db * 32 + 8 * q + 4 * hh) = w; }
}

__device__ __forceinline__ void dilated_tile(const bf16* qkv, bf16* og_all, float* lse_all, int T, ATT_LAS unsigned char* vt, int lane) {
    constexpr int S = 2048, LD = 9216;
    const int r32 = lane & 31, hh = lane >> 5;
    const int bh = T / 192, g = (T >> 6) % 3, idx = T & 63, b = bh >> 4, h = bh & 15;
    const int dil = (g == 0) ? 1 : (g == 1 ? 4 : 16), tiles_per_res = 64 / dil;
    const int res = idx / tiles_per_res, qt = idx % tiles_per_res;
    const bf16* base = qkv + (size_t)b * S * LD + (size_t)res * LD + g * 3072 + h * 64;
    const size_t rs = (size_t)dil * LD;
    const int lq = 32 * qt + r32;
    bf16x8 qf[4]; load_rowfrags(qf, base + (size_t)lq * rs, hh);
    const float slope2 = __builtin_amdgcn_exp2f(-0.5f * (float)(h + 1)) * (float)dil * LOG2E;
    float m = -1e30f, l = 0.f; f32x16 o[2]; o[0] = f32x16{}; o[1] = f32x16{};
    const int kt0 = (qt - 4 < 0) ? 0 : qt - 4;
    for (int kt = kt0; kt <= qt; ++kt) {
        bf16x8 kf[4]; load_rowfrags(kf, base + 1024 + (size_t)(32 * kt + r32) * rs, hh);
        stage_vt(vt, base + 2048 + (size_t)(32 * kt) * rs, rs, lane);
        f32x16 s = qk_tile(kf, qf);
        float mt = -1e30f; bool val[16];
#pragma unroll
        for (int r = 0; r < 16; ++r) { const int rel = lq - (32 * kt + crow(r, hh)); val[r] = (rel >= 0) && (rel <= 128);
            s[r] = s[r] * (0.125f * LOG2E) - slope2 * (float)rel; if (val[r]) mt = fmaxf(mt, s[r]); }
        mt = fmaxf(mt, __shfl_xor(mt, 32));
        const float mn = fmaxf(m, mt), alpha = __builtin_amdgcn_exp2f(m - mn); m = mn;
        float ps = 0.f;
#pragma unroll
        for (int r = 0; r < 16; ++r) { s[r] = val[r] ? __builtin_amdgcn_exp2f(s[r] - mn) : 0.f; ps += s[r]; }
        l = l * alpha + ps;
#pragma unroll
        for (int r = 0; r < 16; ++r) { o[0][r] *= alpha; o[1][r] *= alpha; }
        pv_tile(o, s, vt, lane);
    }
    l += __shfl_xor(l, 32);
    const size_t tok = (size_t)b * S + (size_t)lq * dil + res;
    store_ot(og_all + (size_t)g * ((size_t)32768 * 1024) + tok * 1024 + h * 64, o, 1.0f / l, hh);
    if (hh == 0) lse_all[(size_t)g * (32768 * 16) + tok * 16 + h] = (m + __builtin_amdgcn_logf(l)) * LN2;
}
__device__ __forceinline__ void dilated_combine(const bf16* og_all, const float* lse_all, bf16* y, size_t i  ) {
    const size_t th = i >> 3;
    const float l0 = lse_all[th], l1 = lse_all[(size_t)32768 * 16 + th], l2 = lse_all[(size_t)2 * 32768 * 16 + th];
    const float mx = fmaxf(l0, fmaxf(l1, l2)), e0 = __expf(l0 - mx), e1 = __expf(l1 - mx), e2 = __expf(l2 - mx), inv = 1.0f / (e0 + e1 + e2);
    const float w0 = e0 * inv, w1 = e1 * inv, w2 = e2 * inv;
    const u32x4 a = *(const u32x4*)(og_all + i * 8), bb = *(const u32x4*)(og_all + (size_t)32768 * 1024 + i * 8), c = *(const u32x4*)(og_all + (size_t)2 * 32768 * 1024 + i * 8);
    u32x4 out;
#pragma unroll
    for (int k = 0; k < 4; ++k) {
        const float a0 = __uint_as_float(a[k] << 16), a1 = __uint_as_float(a[k] & 0xffff0000u), b0 = __uint_as_float(bb[k] << 16), b1 = __uint_as_float(bb[k] & 0xffff0000u), c0 = __uint_as_float(c[k] << 16), c1 = __uint_as_float(c[k] & 0xffff0000u);
        out[k] = cvtpk(w0 * a0 + w1 * b0 + w2 * c0, w0 * a1 + w1 * b1 + w2 * c1);
    }
    *(u32x4*)(y + i * 8) = out;
}

__device__ __forceinline__ void sb_tile(const bf16* qkv, bf16* y, int bh, int qt, ATT_LAS unsigned char* vt, int lane) {
    constexpr int S = 2048, LD = 3072;
    const int r32 = lane & 31, hh = lane >> 5, b = bh >> 4, h = bh & 15;
    const bf16* base = qkv + (size_t)b * S * LD + h * 64;
    bf16x8 qf[4]; load_rowfrags(qf, base + (size_t)(32 * qt + r32) * LD, hh);
    f32x16 o[2]; o[0] = f32x16{}; o[1] = f32x16{};
    float R = 0.f;
    for (int kt = qt; kt >= 0; --kt) {
        bf16x8 kf[4]; load_rowfrags(kf, base + 1024 + (size_t)(32 * kt + r32) * LD, hh);
        stage_vt(vt, base + 2048 + (size_t)(32 * kt) * LD, LD, lane);
        f32x16 z = qk_tile(kf, qf);
        const bool diag = (kt == qt);
        f32x16 sp;
#pragma unroll
        for (int r = 0; r < 16; ++r) { z[r] *= 0.125f; const bool valid = !diag || (crow(r, hh) < r32);
            const float e = __builtin_amdgcn_exp2f(-fabsf(z[r]) * LOG2E); const float v = fmaxf(z[r], 0.f) + __builtin_amdgcn_logf(1.0f + e) * LN2; sp[r] = valid ? v : 0.f; }
        float gs[4], og[4];
#pragma unroll
        for (int i = 0; i < 4; ++i) { gs[i] = (sp[4 * i] + sp[4 * i + 1]) + (sp[4 * i + 2] + sp[4 * i + 3]); og[i] = __shfl_xor(gs[i], 32); }
        float so = 0.f, sg = 0.f;
#pragma unroll
        for (int i = 3; i >= 0; --i) {
            const float T = R + so + sg + (hh == 0 ? og[i] : 0.f);
            const float c3 = T + sp[4 * i + 3], c2 = c3 + sp[4 * i + 2], c1 = c2 + sp[4 * i + 1], c0 = c1 + sp[4 * i];
            const bool v0 = !diag || (crow(4 * i, hh) < r32), v1 = !diag || (crow(4 * i + 1, hh) < r32), v2 = !diag || (crow(4 * i + 2, hh) < r32), v3 = !diag || (crow(4 * i + 3, hh) < r32);
            sp[4 * i]     = v0 ? __builtin_amdgcn_exp2f((z[4 * i] - c0) * LOG2E) : 0.f;
            sp[4 * i + 1] = v1 ? __builtin_amdgcn_exp2f((z[4 * i + 1] - c1) * LOG2E) : 0.f;
            sp[4 * i + 2] = v2 ? __builtin_amdgcn_exp2f((z[4 * i + 2] - c2) * LOG2E) : 0.f;
            sp[4 * i + 3] = v3 ? __builtin_amdgcn_exp2f((z[4 * i + 3] - c3) * LOG2E) : 0.f;
            so += gs[i]; sg += og[i];
        }
        R += so + sg;
        pv_tile(o, sp, vt, lane);
    }
    store_ot(y + ((size_t)b * S + 32 * qt + r32) * 1024 + h * 64, o, 1.0f, hh);
}
}
#include <hip/hip_bf16.h>
#include <cmath>
constexpr int DM = 1024, NBATCH = 16, SEQ = 2048, MTOK = NBATCH * SEQ, NHEAD = 16, FF = 3584, NEXP = 8;
constexpr int NQKV_D = 9216, NQKV_S = 3072, NGU = 2 * FF;
constexpr int MP_MAX = 2 * MTOK + NEXP * 256;
constexpr float RMS_EPS = 1e-6f;
constexpr int NWAVES = 8;
constexpr size_t MiB = 1u << 20;
constexpr size_t WS_CTL = 0, CTL_ZERO_BYTES = 1 * MiB;
constexpr size_t WS_RE = 1 * MiB, WS_RW1 = WS_RE + 128 * 1024, WS_RW2 = WS_RW1 + 128 * 1024, WS_POS1 = WS_RW2 + 128 * 1024, WS_POS2 = WS_POS1 + 128 * 1024,
                 WS_GATE = WS_POS2 + 128 * 1024  , WS_CNT = WS_GATE + 512 * 1024  , WS_PTAB = WS_CNT + 16 * 1024  ;
static_assert(WS_PTAB + 4096 <= 4 * MiB, "routing arrays");
constexpr size_t WS_W = 4 * MiB;
constexpr size_t W_IN = 0, W_OUT = W_IN + (size_t)2 * NQKV_D * DM * 2, W_SQKV = W_OUT + (size_t)2 * DM * DM * 2, W_SOUT = W_SQKV + (size_t)2 * NQKV_S * DM * 2,
                 W_FGU = W_SOUT + (size_t)2 * DM * DM * 2, W_FDN = W_FGU + (size_t)2 * NGU * DM * 2, W_MGU = W_FDN + (size_t)2 * DM * FF * 2, W_MDN = W_MGU + (size_t)16 * NGU * DM * 2,
                 W_END = W_MDN + (size_t)16 * DM * FF * 2;
static_assert(W_END == 455081984, "weight bytes");
constexpr size_t WS_H = 440 * MiB, WS_HN = 568 * MiB, WS_Y = 632 * MiB, WS_BIG = 696 * MiB, WS_S = 1272 * MiB, WS_END = 1536 * MiB;
static_assert(WS_W + W_END <= WS_H, "weights fit");
constexpr size_t S_OG = 0, S_LSE = 192 * MiB, S_HNS = 0, S_YS = 132 * MiB;
static_assert((size_t)MP_MAX * DM * 2 == 132 * MiB && (size_t)MTOK * NQKV_D * 2 == 576 * MiB && (size_t)MP_MAX * FF * 2 <= 576 * MiB, "buffer sizes");
constexpr int CW_TMO = 0, CW_BAR = 4096;

constexpr int RING_OFF = 0, RING_BYTES = 131072;
constexpr int LDSCTL_OFF = RING_BYTES, MISC_OFF = LDSCTL_OFF + 320;
constexpr int LDS_BYTES = 147456;
static_assert(MISC_OFF + 128 <= LDS_BYTES, "LDS map");
#define GAS __attribute__((address_space(1)))
#define LAS __attribute__((address_space(3)))
typedef unsigned short bf16;
typedef unsigned v4u __attribute__((ext_vector_type(4)));
typedef float f32x4 __attribute__((ext_vector_type(4)));
typedef short bf16x8 __attribute__((ext_vector_type(8)));
typedef GAS unsigned gu32;
typedef GAS unsigned long long gu64;
#define RLX_AGENT __ATOMIC_RELAXED, __HIP_MEMORY_SCOPE_AGENT
#define LDS_WAIT() asm volatile("s_waitcnt lgkmcnt(0)" ::: "memory")
#define VM_WAIT() asm volatile("s_waitcnt vmcnt(0)" ::: "memory")
__device__ __forceinline__ unsigned long long rt() { return __builtin_amdgcn_s_memrealtime(); }
__device__ __forceinline__ unsigned f2bf(float f) { unsigned u = __builtin_bit_cast(unsigned, f); return (u + 0x7fffu + ((u >> 16) & 1u)) >> 16; }
__device__ __forceinline__ unsigned pk2(float lo, float hi) { return f2bf(lo) | (f2bf(hi) << 16); }

#define XB_TMO      128
#define XB_XCNT(j)  (256  + 64 * (j))
#define XB_XSUB(j)  (1280 + 64 * (j))
#define XB_XGEN(j)  (2304 + 64 * (j))
#define XB_TOP      3328
#define XB_TOPGEN   3392
#define XCD_BAR_WORDS 3456
#define XB_SPIN_CAP (1u << 18)

__device__ __forceinline__ unsigned xb_ld(unsigned* p)              { return __hip_atomic_load(p, __ATOMIC_RELAXED, __HIP_MEMORY_SCOPE_AGENT); }
__device__ __forceinline__ unsigned xb_add(unsigned* p, unsigned v) { return __hip_atomic_fetch_add(p, v, __ATOMIC_RELAXED, __HIP_MEMORY_SCOPE_AGENT); }
__device__ __forceinline__ unsigned xb_xcc_id() { return (unsigned)__builtin_amdgcn_s_getreg((3 << 11) | 20) & 0xFu; }
#define XB_SPIN(cond, bar) do { unsigned _sp = 0; while (cond) { __builtin_amdgcn_s_sleep(1); \
    if ((++_sp & 255u) == 0u) { if (xb_ld(&(bar)[XB_TMO])) break; if (_sp > XB_SPIN_CAP) { atomicAdd(&(bar)[XB_TMO], 1u); break; } } } } while (0)

struct XcdBarrier {
    unsigned* bar; unsigned x;
    volatile LAS unsigned* st;
};

__device__ __forceinline__ XcdBarrier xcd_barrier_post(unsigned* bar, volatile LAS unsigned* st) {
    XcdBarrier b; b.bar = bar; b.x = xb_xcc_id(); b.st = st;
    if (threadIdx.x == 0) (void)xb_add(&bar[XB_XCNT(b.x)], 1u);
    return b;
}
__device__ __forceinline__ void xcd_barrier_complete(unsigned* bar, unsigned x, unsigned& nloc, unsigned& nx) {
    const unsigned G = gridDim.x * gridDim.y * gridDim.z;
    unsigned sum, cnt, mine, sp = 0u;
    for (;;) {
        sum = 0u; cnt = 0u; mine = 0u;
#pragma unroll
        for (unsigned j = 0; j < 16; ++j) { const unsigned c = xb_ld(&bar[XB_XCNT(j)]); sum += c; cnt += (c > 0u) ? 1u : 0u; mine = (j == x) ? c : mine; }
        if (sum == G) break;
        __builtin_amdgcn_s_sleep(1);
        if ((++sp & 255u) == 0u) { if (xb_ld(&bar[XB_TMO])) break; if (sp > XB_SPIN_CAP) { atomicAdd(&bar[XB_TMO], 1u); break; } }
    }
    nloc = mine > 0u ? mine : 1u; nx = cnt > 0u ? cnt : 1u;
}

__device__ __forceinline__ void xcd_barrier(const XcdBarrier& b) {
    asm volatile("s_waitcnt vmcnt(0)" ::: "memory");
    __syncthreads();
    if (threadIdx.x == 0) {
        unsigned* bar = b.bar;
        __builtin_amdgcn_s_waitcnt(0);
        unsigned nloc = b.st[0], nx = b.st[1];
        if (nloc == 0u) { xcd_barrier_complete(bar, b.x, nloc, nx); b.st[0] = nloc; b.st[1] = nx; }
        const unsigned old = xb_add(&bar[XB_XSUB(b.x)], 1u);
        const unsigned gen = old / nloc;
        if (old + 1u == (gen + 1u) * nloc) {
            __builtin_amdgcn_fence(__ATOMIC_RELEASE, "agent");
            asm volatile("s_waitcnt vmcnt(0)" ::: "memory");
            const unsigned og = xb_add(&bar[XB_TOP], 1u);
            const unsigned tg = og / nx;
            if (og + 1u == (tg + 1u) * nx) xb_add(&bar[XB_TOPGEN], 1u);
            else XB_SPIN(xb_ld(&bar[XB_TOPGEN]) == tg, bar);
            __builtin_amdgcn_fence(__ATOMIC_ACQUIRE, "agent");
            xb_add(&bar[XB_XGEN(b.x)], 1u);
            asm volatile("s_waitcnt vmcnt(0)" ::: "memory");
        } else {
            XB_SPIN(xb_ld(&bar[XB_XGEN(b.x)]) == gen, bar);
            __builtin_amdgcn_fence(__ATOMIC_ACQUIRE, "agent");
            asm volatile("s_waitcnt vmcnt(0)" ::: "memory");
        }
    }
    __syncthreads();
}
struct Frame {
    LAS unsigned char* lds;
    volatile LAS unsigned* MISC;
    gu32* ctl;
    int tid, lane, wave;
    int vcu, G, bx;
};
__device__ __forceinline__ float wave_sum(float v) {
#pragma unroll
    for (int o = 1; o < 64; o <<= 1) v += __shfl_xor(v, o);
    return v;
}
__device__ __forceinline__ int wave_sum_i(int v) {
#pragma unroll
    for (int o = 1; o < 64; o <<= 1) v += __shfl_xor(v, o);
    return v;
}
__device__ __forceinline__ float bf_lo(unsigned w) { return __uint_as_float(w << 16); }
__device__ __forceinline__ float bf_hi(unsigned w) { return __uint_as_float(w & 0xffff0000u); }

__device__ __forceinline__ void transpose_item(const float* W, int K, int N, bf16* WT, int mode, LAS float* scr, int item, int lane) {
    const int nblk = N / 32, kb = item / nblk, nb = item % nblk, k0 = 64 * kb, n0 = 32 * nb;
    int drow0 = n0;
    if (mode == 1) { const int up = (n0 >= FF) ? 1 : 0, c = n0 - up * FF; drow0 = (c >> 7) * 256 + up * 128 + (c & 127); }
#pragma unroll 8
    for (int i = 0; i < 32; ++i) { const int kk = 2 * i + (lane >> 5); scr[kk * 33 + (lane & 31)] = W[(size_t)(k0 + kk) * N + n0 + (lane & 31)]; }
    LDS_WAIT(); asm volatile("" ::: "memory");
    const int c = lane & 7;
#pragma unroll
    for (int j = 0; j < 4; ++j) { const int n = (lane >> 3) + 8 * j; const LAS float* s = scr + (8 * c) * 33 + n;
        v4u o; o.x = pk2(s[0 * 33], s[1 * 33]); o.y = pk2(s[2 * 33], s[3 * 33]); o.z = pk2(s[4 * 33], s[5 * 33]); o.w = pk2(s[6 * 33], s[7 * 33]);
        *(GAS v4u*)(WT + (size_t)(drow0 + n) * K + k0 + 8 * c) = o; }
    LDS_WAIT(); asm volatile("" ::: "memory");
}
__device__ __forceinline__ void conv_family(Frame& F, const float* src, bf16* dst, int nmat, int K, int N, int mode, LAS float* scr) {
    const int gw = F.vcu * NWAVES + F.wave, NGW = F.G * NWAVES;
    const int ipm = (K / 64) * (N / 32), total = nmat * ipm;
    for (int it = gw; it < total; it += NGW) { const int mat = it / ipm, r = it - mat * ipm;
        transpose_item(src + (size_t)mat * K * N, K, N, dst + (size_t)mat * K * N, mode, scr, r, F.lane); }
}

template <int MODE>
__device__ __forceinline__ void norm_rows(Frame& F, const float* src, float* h, bf16* hn, float* out, const float* gain, const bf16* ys, const int* pos1, const int* pos2) {
    const int gw = F.vcu * NWAVES + F.wave, NGW = F.G * NWAVES;
    f32x4 gn[4];
#pragma unroll
    for (int j = 0; j < 4; ++j) gn[j] = *(const f32x4*)(gain + 256 * j + 4 * F.lane);
    for (int m = gw; m < MTOK; m += NGW) {
        const f32x4* xr = (const f32x4*)(src + (size_t)m * DM) + F.lane;
        f32x4 v[4];
#pragma unroll
        for (int j = 0; j < 4; ++j) v[j] = xr[64 * j];
        if (MODE == 2 || MODE == 3) {
            const int p1 = __hip_atomic_load(pos1 + m, __ATOMIC_RELAXED, __HIP_MEMORY_SCOPE_AGENT), p2 = __hip_atomic_load(pos2 + m, __ATOMIC_RELAXED, __HIP_MEMORY_SCOPE_AGENT);
            const unsigned long long* y1 = (const unsigned long long*)(ys + (size_t)p1 * DM) + F.lane; const unsigned long long* y2 = (const unsigned long long*)(ys + (size_t)p2 * DM) + F.lane;
#pragma unroll
            for (int j = 0; j < 4; ++j) { const unsigned long long a = y1[64 * j], b = y2[64 * j]; const unsigned a0 = (unsigned)a, a1 = (unsigned)(a >> 32), b0 = (unsigned)b, b1 = (unsigned)(b >> 32);
                v[j].x += bf_lo(a0) + bf_lo(b0); v[j].y += bf_hi(a0) + bf_hi(b0); v[j].z += bf_lo(a1) + bf_lo(b1); v[j].w += bf_hi(a1) + bf_hi(b1); }
        }
        if (MODE == 0 || MODE == 2) { f32x4* hr = (f32x4*)(h + (size_t)m * DM) + F.lane;
#pragma unroll
            for (int j = 0; j < 4; ++j) hr[64 * j] = v[j]; }
        float s2 = 0.f;
#pragma unroll
        for (int j = 0; j < 4; ++j) s2 += (v[j].x * v[j].x + v[j].y * v[j].y) + (v[j].z * v[j].z + v[j].w * v[j].w);
        const float rstd = 1.f / sqrtf(wave_sum(s2) * (1.f / DM) + RMS_EPS);
        if (MODE == 3) { f32x4* orow = (f32x4*)(out + (size_t)m * DM) + F.lane;
#pragma unroll
            for (int j = 0; j < 4; ++j) orow[64 * j] = v[j] * rstd * gn[j];
        } else { unsigned long long* o8 = (unsigned long long*)(hn + (size_t)m * DM) + F.lane;
#pragma unroll
            for (int j = 0; j < 4; ++j) { const f32x4 t = v[j] * rstd * gn[j]; o8[64 * j] = (unsigned long long)pk2(t.x, t.y) | ((unsigned long long)pk2(t.z, t.w) << 32); } }
    }
}

__device__ __forceinline__ void router_part1(Frame& F, const float* h, bf16* hn, const float* gain, const float* wr  , int* re, float* rw1, float* rw2, int* cnt_g) {
    LAS int* wc = (LAS int*)(F.lds + RING_OFF);
    f32x4 gn[4];
#pragma unroll
    for (int j = 0; j < 4; ++j) gn[j] = *(const f32x4*)(gain + 256 * j + 4 * F.lane);
    for (int tb = F.bx; tb < MTOK / 128; tb += F.G) {
        int c0 = 0, c1 = 0, c2 = 0, c3 = 0, c4 = 0, c5 = 0, c6 = 0, c7 = 0;
        for (int i = 0; i < 16; ++i) {
            const int m = tb * 128 + F.wave * 16 + i;
            const f32x4* xr = (const f32x4*)(h + (size_t)m * DM) + F.lane;
            f32x4 v[4]; float s2 = 0.f;
#pragma unroll
            for (int j = 0; j < 4; ++j) { v[j] = xr[64 * j]; s2 += (v[j].x * v[j].x + v[j].y * v[j].y) + (v[j].z * v[j].z + v[j].w * v[j].w); }
            const float rstd = 1.f / sqrtf(wave_sum(s2) * (1.f / DM) + RMS_EPS);
            float lg[8] = {0.f, 0.f, 0.f, 0.f, 0.f, 0.f, 0.f, 0.f};
            unsigned long long* o8 = (unsigned long long*)(hn + (size_t)m * DM) + F.lane;
#pragma unroll
            for (int j = 0; j < 4; ++j) { const f32x4 t = v[j] * rstd * gn[j]; o8[64 * j] = (unsigned long long)pk2(t.x, t.y) | ((unsigned long long)pk2(t.z, t.w) << 32);
#pragma unroll
                for (int q = 0; q < 4; ++q) { const f32x4* w4 = (const f32x4*)(wr + (size_t)(256 * j + 4 * F.lane + q) * 8); const f32x4 wa = w4[0], wb = w4[1]; const float tv = t[q];
                    lg[0] += tv * wa.x; lg[1] += tv * wa.y; lg[2] += tv * wa.z; lg[3] += tv * wa.w; lg[4] += tv * wb.x; lg[5] += tv * wb.y; lg[6] += tv * wb.z; lg[7] += tv * wb.w; } }
#pragma unroll
            for (int e = 0; e < 8; ++e) lg[e] = wave_sum(lg[e]);
            int e1 = 0; float v1 = lg[0];
#pragma unroll
            for (int e = 1; e < 8; ++e) if (lg[e] > v1) { v1 = lg[e]; e1 = e; }
            int e2 = -1; float v2 = -INFINITY;
#pragma unroll
            for (int e = 0; e < 8; ++e) if (e != e1 && lg[e] > v2) { v2 = lg[e]; e2 = e; }
            const float w1 = 1.0f / (1.0f + __expf(v2 - v1)), w2 = 1.0f - w1;
            if (F.lane == 0) { re[m] = e1 | (e2 << 8); rw1[m] = w1; rw2[m] = w2; }
            c0 += (e1 == 0) + (e2 == 0); c1 += (e1 == 1) + (e2 == 1); c2 += (e1 == 2) + (e2 == 2); c3 += (e1 == 3) + (e2 == 3);
            c4 += (e1 == 4) + (e2 == 4); c5 += (e1 == 5) + (e2 == 5); c6 += (e1 == 6) + (e2 == 6); c7 += (e1 == 7) + (e2 == 7);
        }
        if (F.lane == 0) { LAS int* w = wc + F.wave * 8; w[0] = c0; w[1] = c1; w[2] = c2; w[3] = c3; w[4] = c4; w[5] = c5; w[6] = c6; w[7] = c7; }
        __syncthreads();
        if (F.tid < 8) { int s = 0;
#pragma unroll
            for (int w = 0; w < 8; ++w) s += wc[w * 8 + F.tid];
            cnt_g[tb * 8 + F.tid] = s; }
        __syncthreads();
    }
}
__device__ __forceinline__ void router_part2(Frame& F, const bf16* hn, bf16* hns, const int* re, const float* rw1, const float* rw2, const int* cnt_g, int* pos1, int* pos2, float* gate, unsigned* ptab) {
    LAS int* cg = (LAS int*)(F.lds + RING_OFF);
    LAS int* tot = cg + 2048; LAS int* pre = cg + 2056; LAS int* wcnt = cg + 2064;
    for (int tb = F.bx; tb < MTOK / 128; tb += F.G) {
        for (int k = F.tid; k < 2048; k += NWAVES * 64) cg[k] = cnt_g[k];
        __syncthreads();
        { const int e = F.wave; int t = 0, p = 0;
#pragma unroll
          for (int q = 0; q < 4; ++q) { const int c = F.lane * 4 + q; const int v = cg[c * 8 + e]; t += v; p += (c < tb) ? v : 0; }
          t = wave_sum_i(t); p = wave_sum_i(p);
          if (F.lane == 0) { tot[e] = t; pre[e] = p; } }
        const bool act = F.lane < 16;
        const int m = tb * 128 + F.wave * 16 + (F.lane & 15);
        const int ee = re[m], e1 = ee & 0xff, e2 = (ee >> 8) & 0xff;
        unsigned long long mk[8];
#pragma unroll
        for (int e = 0; e < 8; ++e) { mk[e] = __ballot(act && (e1 == e || e2 == e)); if (F.lane == e) wcnt[F.wave * 8 + e] = __popcll(mk[e]); }
        __syncthreads();
        int seg = 0, p1 = 0, p2 = 0, mypad0 = 0, mypad1 = 0;
        const unsigned long long lt = (1ull << F.lane) - 1ull;
#pragma unroll
        for (int e = 0; e < 8; ++e) {
            const int te = tot[e]; int bse = seg + pre[e];
            for (int w = 0; w < F.wave; ++w) bse += wcnt[w * 8 + e];
            const int rank = __popcll(mk[e] & lt);
            if (e1 == e) p1 = bse + rank;
            if (e2 == e) p2 = bse + rank;
            const int segn = seg + ((te + 255) & ~255);
            if (tb == e) { mypad0 = seg + te; mypad1 = segn; }
            if (tb == 0) { for (int p = seg / 256 + F.tid; p < segn / 256; p += NWAVES * 64) __hip_atomic_store(ptab + 64 + p, (unsigned)e, __ATOMIC_RELAXED, __HIP_MEMORY_SCOPE_AGENT); }
            seg = segn;
        }
        if (tb == 0 && F.tid == 0) __hip_atomic_store(ptab, (unsigned)(seg / 256), __ATOMIC_RELAXED, __HIP_MEMORY_SCOPE_AGENT);
        if (act) { pos1[m] = p1; pos2[m] = p2; gate[p1] = rw1[m]; gate[p2] = rw2[m]; }
#pragma unroll
        for (int i = 0; i < 16; ++i) {
            const int q1 = __builtin_amdgcn_readlane(p1, i), q2 = __builtin_amdgcn_readlane(p2, i);
            const bf16* srow = hn + (size_t)(tb * 128 + F.wave * 16 + i) * DM;
            const v4u a = *(const GAS v4u*)(srow + F.lane * 8), b = *(const GAS v4u*)(srow + 512 + F.lane * 8);
            *(GAS v4u*)(hns + (size_t)q1 * DM + F.lane * 8) = a; *(GAS v4u*)(hns + (size_t)q1 * DM + 512 + F.lane * 8) = b;
            *(GAS v4u*)(hns + (size_t)q2 * DM + F.lane * 8) = a; *(GAS v4u*)(hns + (size_t)q2 * DM + 512 + F.lane * 8) = b;
        }
        if (tb < 8) {
            const v4u z = {0u, 0u, 0u, 0u};
            for (int r = mypad0 + F.wave; r < mypad1; r += NWAVES) { *(GAS v4u*)(hns + (size_t)r * DM + F.lane * 8) = z; *(GAS v4u*)(hns + (size_t)r * DM + 512 + F.lane * 8) = z; if (F.lane == 0) gate[r] = 0.f; }
        }
        __syncthreads();
    }
}
constexpr int N_PHASES = 34;
struct Args { const float* x; const float* mix_norm; const float* ffn_norm; const float* dil_w_in; const float* dil_w_out; const float* sb_w_qkv; const float* sb_w_out;
              const float* ffn_gu; const float* ffn_dn; const float* moe_router; const float* moe_gu; const float* moe_dn; const float* final_norm; float* out; unsigned char* ws; int lo, hi, li, pad; };
typedef const __attribute__((address_space(4))) Args* KArgs;
__device__ __forceinline__ KArgs kargs() { KArgs p = (KArgs)__builtin_amdgcn_kernarg_segment_ptr(); asm volatile("" : "+s"(p)); return p; }
__device__ __forceinline__ void make_frame(Frame& F, LAS unsigned char* lds, unsigned char* ws) {
    int t = threadIdx.x; asm volatile("" : "+v"(t));
    int bx = blockIdx.x, G = gridDim.x; asm volatile("" : "+s"(bx), "+s"(G));
    F.lds = lds; F.MISC = (volatile LAS unsigned*)(lds + MISC_OFF); F.ctl = (gu32*)(ws + WS_CTL);
    F.tid = t; F.lane = t & 63; F.wave = __builtin_amdgcn_readfirstlane(t >> 6);
    F.G = G; F.vcu = (G % 8 == 0) ? (bx % 8) * (G / 8) + bx / 8 : bx; F.bx = bx;
}
#define WPTR(off) ((bf16*)(ws + WS_W + (off)))
__global__ void __launch_bounds__(NWAVES * 64, 2) mk_fwd(Args a_) {
    extern __shared__ __attribute__((aligned(16))) unsigned char lds_[];
    LAS unsigned char* const lds = (LAS unsigned char*)lds_;
    for (int u = threadIdx.x; u < (LDS_BYTES - LDSCTL_OFF) / 4; u += NWAVES * 64) ((LAS unsigned*)(lds + LDSCTL_OFF))[u] = 0u;
    __syncthreads();
    int lo, hi;
    XcdBarrier bar;
    { KArgs ka = kargs(); lo = ka->lo; hi = ka->hi; unsigned* bw = (unsigned*)(ka->ws + WS_CTL) + CW_BAR + ka->li * XCD_BAR_WORDS;
      bar.bar = bw; bar.x = 0; bar.st = nullptr;
      if (hi - lo > 1) bar = xcd_barrier_post(bw, (volatile LAS unsigned*)(lds + MISC_OFF) + 8); }
#define IN(k) (lo <= (k) && (k) < hi)
#define SEAM(k) do { if (IN(k) && IN((k) + 1)) xcd_barrier(bar); } while (0)
#define CTX() KArgs ka = kargs(); unsigned char* const ws = ka->ws; Frame F; make_frame(F, lds, ws); LAS unsigned char* const ring = lds + RING_OFF; (void)ring

    if (IN(0)) { CTX();
        LAS float* scr = (LAS float*)(ring + F.wave * 16384);
        conv_family(F, ka->dil_w_in,  WPTR(W_IN),   2, DM, NQKV_D, 0, scr);
        conv_family(F, ka->dil_w_out, WPTR(W_OUT),  2, DM, DM,     0, scr);
        conv_family(F, ka->sb_w_qkv,  WPTR(W_SQKV), 2, DM, NQKV_S, 0, scr);
        conv_family(F, ka->sb_w_out,  WPTR(W_SOUT), 2, DM, DM,     0, scr);
        conv_family(F, ka->ffn_gu,    WPTR(W_FGU),  2, DM, NGU,    1, scr);
        conv_family(F, ka->ffn_dn,    WPTR(W_FDN),  2, FF, DM,     0, scr);
        conv_family(F, ka->moe_gu,    WPTR(W_MGU), 16, DM, NGU,    1, scr);
        conv_family(F, ka->moe_dn,    WPTR(W_MDN), 16, FF, DM,     0, scr);
    }
    SEAM(0);

    for (int lp = 0; lp < 2; ++lp) {
        const int pb = 1 + 16 * lp;
        if (IN(pb + 0)) { CTX();
            if (lp == 0) norm_rows<0>(F, ka->x, (float*)(ws + WS_H), (bf16*)(ws + WS_HN), nullptr, ka->mix_norm + (size_t)(2 * lp) * DM, nullptr, nullptr, nullptr);
            else         norm_rows<2>(F, (const float*)(ws + WS_H), (float*)(ws + WS_H), (bf16*)(ws + WS_HN), nullptr, ka->mix_norm + (size_t)(2 * lp) * DM, (const bf16*)(ws + WS_S + S_YS), (const int*)(ws + WS_POS1), (const int*)(ws + WS_POS2));
        }
        SEAM(pb + 0);
        if (IN(pb + 1)) { CTX(); pg8::Gemm g{(const bf16*)(ws + WS_HN), WPTR(W_IN) + (size_t)lp * NQKV_D * DM, MTOK, NQKV_D, DM}; pg8::StaticOrder S; S.init(MTOK, NQKV_D, F.G, F.bx); pg8::EpiStore E{(bf16*)(ws + WS_BIG), NQKV_D};
            pg8::gemm_phase<pg8::EpiStore, pg8::StaticOrder, true, true>(ring, g, S, E); }
        SEAM(pb + 1);
        if (IN(pb + 2)) { CTX(); LAS unsigned char* vt = ring + F.wave * att::VT_BYTES;
            for (int U = F.vcu; U < 256 * 3 * 64 / 8; U += F.G) att::dilated_tile((const bf16*)(ws + WS_BIG), (bf16*)(ws + WS_S + S_OG), (float*)(ws + WS_S + S_LSE), U * 8 + F.wave, vt, F.lane); }
        SEAM(pb + 2);
        if (IN(pb + 3)) { CTX(); for (size_t i = (size_t)F.vcu * (NWAVES * 64) + F.tid; i < (size_t)MTOK * 128; i += (size_t)F.G * NWAVES * 64) att::dilated_combine((const bf16*)(ws + WS_S + S_OG), (const float*)(ws + WS_S + S_LSE), (bf16*)(ws + WS_Y), i); }
        SEAM(pb + 3);
        if (IN(pb + 4)) { CTX(); pg8::Gemm g{(const bf16*)(ws + WS_Y), WPTR(W_OUT) + (size_t)lp * DM * DM, MTOK, DM, DM}; pg8::StaticOrder S; S.init(MTOK, DM, F.G, F.bx); pg8::EpiResid E{(float*)(ws + WS_H), DM};
            pg8::gemm_phase<pg8::EpiResid, pg8::StaticOrder, true, true>(ring, g, S, E); }
        SEAM(pb + 4);
        if (IN(pb + 5)) { CTX(); norm_rows<1>(F, (const float*)(ws + WS_H), nullptr, (bf16*)(ws + WS_HN), nullptr, ka->ffn_norm + (size_t)(2 * lp) * DM, nullptr, nullptr, nullptr); }
        SEAM(pb + 5);
        if (IN(pb + 6)) { CTX(); pg8::Gemm g{(const bf16*)(ws + WS_HN), WPTR(W_FGU) + (size_t)lp * NGU * DM, MTOK, NGU, DM}; pg8::StaticOrder S; S.init(MTOK, NGU, F.G, F.bx); pg8::EpiSwiGLU E{(bf16*)(ws + WS_BIG), FF};
            pg8::gemm_phase<pg8::EpiSwiGLU, pg8::StaticOrder, true, true>(ring, g, S, E); }
        SEAM(pb + 6);
        if (IN(pb + 7)) { CTX(); pg8::Gemm g{(const bf16*)(ws + WS_BIG), WPTR(W_FDN) + (size_t)lp * DM * FF, MTOK, DM, FF}; pg8::StaticOrder S; S.init(MTOK, DM, F.G, F.bx); pg8::EpiResid E{(float*)(ws + WS_H), DM};
            pg8::gemm_phase<pg8::EpiResid, pg8::StaticOrder, true, true>(ring, g, S, E); }
        SEAM(pb + 7);
        if (IN(pb + 8)) { CTX(); norm_rows<1>(F, (const float*)(ws + WS_H), nullptr, (bf16*)(ws + WS_HN), nullptr, ka->mix_norm + (size_t)(2 * lp + 1) * DM, nullptr, nullptr, nullptr); }
        SEAM(pb + 8);
        if (IN(pb + 9)) { CTX(); pg8::Gemm g{(const bf16*)(ws + WS_HN), WPTR(W_SQKV) + (size_t)lp * NQKV_S * DM, MTOK, NQKV_S, DM}; pg8::StaticOrder S; S.init(MTOK, NQKV_S, F.G, F.bx); pg8::EpiStore E{(bf16*)(ws + WS_BIG), NQKV_S};
            pg8::gemm_phase<pg8::EpiStore, pg8::StaticOrder, true, true>(ring, g, S, E); }
        SEAM(pb + 9);
        if (IN(pb + 10)) { CTX(); LAS unsigned char* vt = ring + F.wave * att::VT_BYTES;
            for (int k = 0; F.vcu + k * F.G < 2048; ++k) { const int U = F.vcu + k * F.G, bh = U >> 3, sub = ((U & 7) + k) & 7;
                att::sb_tile((const bf16*)(ws + WS_BIG), (bf16*)(ws + WS_Y), bh, sub * 8 + F.wave, vt, F.lane); } }
        SEAM(pb + 10);
        if (IN(pb + 11)) { CTX(); pg8::Gemm g{(const bf16*)(ws + WS_Y), WPTR(W_SOUT) + (size_t)lp * DM * DM, MTOK, DM, DM}; pg8::StaticOrder S; S.init(MTOK, DM, F.G, F.bx); pg8::EpiResid E{(float*)(ws + WS_H), DM};
            pg8::gemm_phase<pg8::EpiResid, pg8::StaticOrder, true, true>(ring, g, S, E); }
        SEAM(pb + 11);
        if (IN(pb + 12)) { CTX(); router_part1(F, (const float*)(ws + WS_H), (bf16*)(ws + WS_HN), ka->ffn_norm + (size_t)(2 * lp + 1) * DM, ka->moe_router + (size_t)lp * DM * NEXP,
                                               (int*)(ws + WS_RE), (float*)(ws + WS_RW1), (float*)(ws + WS_RW2), (int*)(ws + WS_CNT)); }
        SEAM(pb + 12);
        if (IN(pb + 13)) { CTX(); router_part2(F, (const bf16*)(ws + WS_HN), (bf16*)(ws + WS_S + S_HNS), (const int*)(ws + WS_RE), (const float*)(ws + WS_RW1), (const float*)(ws + WS_RW2), (const int*)(ws + WS_CNT),
                                               (int*)(ws + WS_POS1), (int*)(ws + WS_POS2), (float*)(ws + WS_GATE), (unsigned*)(ws + WS_PTAB)); }
        SEAM(pb + 13);
        if (IN(pb + 14)) { CTX(); unsigned* ptab = (unsigned*)(ws + WS_PTAB); const int npan = (int)__builtin_amdgcn_readfirstlane(__hip_atomic_load(ptab, __ATOMIC_RELAXED, __HIP_MEMORY_SCOPE_AGENT));
            pg8::Gemm g{(const bf16*)(ws + WS_S + S_HNS), WPTR(W_MGU) + (size_t)lp * NEXP * NGU * DM, npan * 256, NGU, DM}; pg8::StaticOrder S; S.init(npan * 256, NGU, F.G, F.bx, ptab + 64); pg8::EpiSwiGLU E{(bf16*)(ws + WS_BIG), FF};
            pg8::gemm_phase<pg8::EpiSwiGLU, pg8::StaticOrder, true, true>(ring, g, S, E); }
        SEAM(pb + 14);
        if (IN(pb + 15)) { CTX(); unsigned* ptab = (unsigned*)(ws + WS_PTAB); const int npan = (int)__builtin_amdgcn_readfirstlane(__hip_atomic_load(ptab, __ATOMIC_RELAXED, __HIP_MEMORY_SCOPE_AGENT));
            pg8::Gemm g{(const bf16*)(ws + WS_BIG), WPTR(W_MDN) + (size_t)lp * NEXP * DM * FF, npan * 256, DM, FF}; pg8::StaticOrder S; S.init(npan * 256, DM, F.G, F.bx, ptab + 64); pg8::EpiMoeDown E{(bf16*)(ws + WS_S + S_YS), DM, (const float*)(ws + WS_GATE)};
            pg8::gemm_phase<pg8::EpiMoeDown, pg8::StaticOrder, true, true>(ring, g, S, E); }
        SEAM(pb + 15);
    }
    if (IN(33)) { CTX(); norm_rows<3>(F, (const float*)(ws + WS_H), nullptr, nullptr, ka->out, ka->final_norm, (const bf16*)(ws + WS_S + S_YS), (const int*)(ws + WS_POS1), (const int*)(ws + WS_POS2)); }
#undef IN
#undef SEAM
#undef CTX
}

#ifndef MK_SINGLE
#define MK_SINGLE 0
#endif
extern "C" void kernel_launch(void* const* d_in, const int* in_sizes, int n_in, void* d_out, int out_size, void* d_ws, size_t ws_size, hipStream_t stream) {
    static int grid = 0;
    if (grid == 0) {
        if (n_in != 13 || in_sizes[0] != MTOK * DM || out_size != MTOK * DM || ws_size < WS_END) { fprintf(stderr, "kernel_launch: unexpected shapes / workspace (n_in %d, ws %zu)\n", n_in, ws_size); grid = -1; return; }
        int dev = 0, cus = 0, per_cu = 0;
        if (hipGetDevice(&dev) != hipSuccess || hipDeviceGetAttribute(&cus, hipDeviceAttributeMultiprocessorCount, dev) != hipSuccess) { grid = -1; return; }
        if (hipFuncSetAttribute((const void*)mk_fwd, hipFuncAttributeMaxDynamicSharedMemorySize, LDS_BYTES) != hipSuccess) { grid = -1; return; }
        if (hipOccupancyMaxActiveBlocksPerMultiprocessor(&per_cu, (const void*)mk_fwd, NWAVES * 64, LDS_BYTES) != hipSuccess || per_cu < 1) { fprintf(stderr, "kernel_launch: occupancy query says %d\n", per_cu); }
        (void)hipGetLastError();
        grid = cus;
    }
    if (grid < 0) return;
    if (hipMemsetAsync((char*)d_ws + WS_CTL, 0, CTL_ZERO_BYTES, stream) != hipSuccess) return;
    Args a{};
    a.x = (const float*)d_in[0]; a.mix_norm = (const float*)d_in[1]; a.ffn_norm = (const float*)d_in[2]; a.dil_w_in = (const float*)d_in[3]; a.dil_w_out = (const float*)d_in[4];
    a.sb_w_qkv = (const float*)d_in[5]; a.sb_w_out = (const float*)d_in[6]; a.ffn_gu = (const float*)d_in[7]; a.ffn_dn = (const float*)d_in[8]; a.moe_router = (const float*)d_in[9];
    a.moe_gu = (const float*)d_in[10]; a.moe_dn = (const float*)d_in[11]; a.final_norm = (const float*)d_in[12]; a.out = (float*)d_out; a.ws = (unsigned char*)d_ws; a.pad = 0;
#if MK_SINGLE
    a.lo = 0; a.hi = N_PHASES; a.li = 0;
    hipLaunchKernelGGL(mk_fwd, dim3(grid), dim3(NWAVES * 64), LDS_BYTES, stream, a);
#else
    for (int ph = 0; ph < N_PHASES; ++ph) { a.lo = ph; a.hi = ph + 1; a.li = 0; hipLaunchKernelGGL(mk_fwd, dim3(grid), dim3(NWAVES * 64), LDS_BYTES, stream, a); }
#endif
}
```

```cpp
#include <hip/hip_runtime.h>
#include <cstdio>
#include <cstdint>
__device__ __forceinline__ int lane_id_v() { int l; asm volatile("v_mbcnt_lo_u32_b32 %0, -1, 0\n\tv_mbcnt_hi_u32_b32 %0, -1, %0" : "=v"(l)); return l; }
template <int O> __device__ __forceinline__ unsigned xshfl_u(unsigned v) {
    if constexpr (O >= 32) { auto r = __builtin_amdgcn_permlane32_swap(v, v, false, false); return (lane_id_v() < 32) ? r[1] : r[0]; }
    else return (unsigned)__builtin_amdgcn_ds_swizzle((int)v, (O << 10) | 0x1F);
}
template <int O> __device__ __forceinline__ float xshfl(float v) { return __uint_as_float(xshfl_u<O>(__float_as_uint(v))); }
template <int O> __device__ __forceinline__ int xshfl(int v) { return (int)xshfl_u<O>((unsigned)v); }
template <int CTRL> __device__ __forceinline__ float dppf(float v) { return __int_as_float(__builtin_amdgcn_update_dpp(0, __float_as_int(v), CTRL, 0xF, 0xF, true)); }
template <int CTRL> __device__ __forceinline__ int dppi(int v) { return __builtin_amdgcn_update_dpp(0, v, CTRL, 0xF, 0xF, true); }
__device__ __forceinline__ float wave_sum(float v) {
    v += dppf<0xB1>(v); v += dppf<0x4E>(v); v += dppf<0x141>(v); v += dppf<0x140>(v);
    { auto r = __builtin_amdgcn_permlane16_swap(__float_as_uint(v), __float_as_uint(v), false, false); v = __uint_as_float(r[0]) + __uint_as_float(r[1]); }
    { auto r = __builtin_amdgcn_permlane32_swap(__float_as_uint(v), __float_as_uint(v), false, false); v = __uint_as_float(r[0]) + __uint_as_float(r[1]); }
    return v;
}
__device__ __forceinline__ float wave_max(float v) {
    v = fmaxf(v, dppf<0xB1>(v)); v = fmaxf(v, dppf<0x4E>(v)); v = fmaxf(v, dppf<0x141>(v)); v = fmaxf(v, dppf<0x140>(v));
    { auto r = __builtin_amdgcn_permlane16_swap(__float_as_uint(v), __float_as_uint(v), false, false); v = fmaxf(__uint_as_float(r[0]), __uint_as_float(r[1])); }
    { auto r = __builtin_amdgcn_permlane32_swap(__float_as_uint(v), __float_as_uint(v), false, false); v = fmaxf(__uint_as_float(r[0]), __uint_as_float(r[1])); }
    return v;
}
__device__ __forceinline__ int wave_sum_i(int v) {
    v += dppi<0xB1>(v); v += dppi<0x4E>(v); v += dppi<0x141>(v); v += dppi<0x140>(v);
    { auto r = __builtin_amdgcn_permlane16_swap((unsigned)v, (unsigned)v, false, false); v = (int)(r[0] + r[1]); }
    { auto r = __builtin_amdgcn_permlane32_swap((unsigned)v, (unsigned)v, false, false); v = (int)(r[0] + r[1]); }
    return v;
}
namespace pg8 {
#define PG8_LAS __attribute__((address_space(3)))
typedef unsigned short bf16_t;
typedef short bf16x8 __attribute__((ext_vector_type(8)));
typedef float f32x4 __attribute__((ext_vector_type(4)));
typedef unsigned u32x4 __attribute__((ext_vector_type(4)));
typedef int i32x4 __attribute__((ext_vector_type(4)));
template <bool I8> struct Mma;
template <> struct Mma<false> { typedef f32x4 acc_t; static __device__ __forceinline__ acc_t run(bf16x8 b, bf16x8 a, acc_t c) { return __builtin_amdgcn_mfma_f32_16x16x32_bf16(b, a, c, 0, 0, 0); } };
template <> struct Mma<true>  { typedef i32x4 acc_t; static __device__ __forceinline__ acc_t run(bf16x8 b, bf16x8 a, acc_t c) { return __builtin_amdgcn_mfma_i32_16x16x64_i8(__builtin_bit_cast(i32x4, b), __builtin_bit_cast(i32x4, a), c, 0, 0, 0); } };
constexpr int BM = 256, BK = 64, HALF = 128, HTB = HALF * BK * 2  , STAGE_BYTES = 8 * HTB, NXCD = 8, WGM = 4;

__host__ __device__ __forceinline__ int lds_byte(int r, int c) { const int st = (r >> 4) * 2 + (c >> 5), rr = r & 15, cc = c & 31, ob = rr * 64 + cc * 2; return st * 1024 + (ob ^ (((ob >> 9) & 1) << 5)); }
__host__ __device__ __forceinline__ void stage_rc(int b, int& R, int& C) { const int st = b / 1024, sb = b % 1024, swz = sb ^ (((sb >> 9) & 1) << 5); R = (st >> 1) * 16 + swz / 64; C = (st & 1) * 32 + (swz % 64) / 2; }
__host__ __device__ __forceinline__ int perm32(int rho) { const int n = rho >> 4, i = rho & 15; return 8 * (i >> 2) + 4 * n + (i & 3); }

struct Unit { int pm, pn, pb, koff, aux; };
struct Gemm { const bf16_t* A; const bf16_t* Bt; int M, N, K, ld = 0; };

template <int NN  > struct StaticOrderT {
    int nM, nN, nwg, G, c, wave_s, probe_same = 0; const unsigned* pexp; int segp[7];
    __device__ __forceinline__ void init(int M, int N, int G_, int c_, int wave_s_, const unsigned* pexp_ = nullptr) { nM = M / BM; nN = NN; nwg = nM * NN; G = G_; c = c_; wave_s = wave_s_; pexp = pexp_;
        if (pexp) {
#pragma unroll
            for (int e = 0; e < 7; ++e) segp[e] = (int)__builtin_amdgcn_readfirstlane(__hip_atomic_load(pexp - 32 + e, __ATOMIC_RELAXED, __HIP_MEMORY_SCOPE_AGENT)); } }
    int limit = 0x7fffffff;
    __device__ __forceinline__ void map(int L, Unit& u) const {
        int wgid = L; { const int q = nwg / NXCD, r = nwg % NXCD, xcd = wgid % NXCD, off = wgid / NXCD; wgid = (xcd < r ? xcd * (q + 1) : r * (q + 1) + (xcd - r) * q) + off; }
        constexpr int nig = WGM * NN; const int gid = wgid / nig, rem = wgid - gid * nig, fm = gid * WGM, gsz = (nM - fm) < WGM ? (nM - fm) : WGM;
        if (gsz == WGM) { u.pm = fm + rem % WGM; u.pn = rem / WGM; } else { u.pm = fm + rem % gsz; u.pn = rem / gsz; }
        u.koff = 0; u.aux = 0;
        if (probe_same) { u.pm = 0; u.pn = 0; }
        if (pexp) { int ex = 0;
#pragma unroll
            for (int e = 0; e < 7; ++e) ex += (u.pm >= segp[e]) ? 1 : 0;
            u.pb = ex * NN + u.pn; } else u.pb = u.pn;
    }
    __device__ __forceinline__ bool next(int i, Unit& u) const {
        const long L = (long)i * G + c; if (L >= nwg || L >= limit) return false;
        map((int)L, u); return true;
    }
    __device__ __forceinline__ void a_ready(const Unit&) const {}
    __device__ __forceinline__ void done(const Unit&) const {}
};


__device__ __forceinline__ unsigned cvt_pk_bf16(float lo, float hi) { unsigned r; asm volatile("v_cvt_pk_bf16_f32 %0, %1, %2" : "=v"(r) : "v"(lo), "v"(hi)); return r; }
template <class Epi, class Sched, bool ALIGN_EPI = false, bool SP2 = false>
__device__ __forceinline__ void gemm_phase(PG8_LAS unsigned char* lds, const Gemm g, const Sched& S, const Epi& E, unsigned skew_ticks = 0) {
    if (skew_ticks) { const unsigned long long t0_ = __builtin_amdgcn_s_memrealtime(); while (__builtin_amdgcn_s_memrealtime() - t0_ < (unsigned long long)skew_ticks) __builtin_amdgcn_s_sleep(8); }
    const int tid_ = S.wave_s * 64 + lane_id_v();
    const int tid = tid_, wid = __builtin_amdgcn_readfirstlane(tid >> 6), lane = tid & 63, wr = wid >> 2, wc = wid & 3, fr = lane & 15, fq = lane >> 4;
    const int K = g.K, nt = K / BK, ld = g.ld ? g.ld : g.K;
    unsigned voffA[2], voffB[2];
#pragma unroll
    for (int i = 0; i < 2; ++i) { int R, C; stage_rc(tid * 16 + i * 8192, R, C); const int Rb = Epi::PERM ? ((R & ~31) + perm32(R & 31)) : R;
        voffA[i] = (unsigned)(R * ld + C) * 2u; voffB[i] = (unsigned)(Rb * ld + C) * 2u; }
    const size_t kstep = (size_t)(BK * 2);
    const size_t hstep = (size_t)HALF * ld * 2;
    const size_t tstep = 2 * hstep;
    const unsigned ldsw = (unsigned)wid * 1024u;
    const int aoff = lds_byte(wr * 64 + fr, fq * 8), boff = lds_byte(wc * 32 + fr, fq * 8);
#define PG8_SA(b, h) (((b) * 2 + (h)) * HTB)
#define PG8_SB(b, h) ((4 + (b) * 2 + (h)) * HTB)
#define PG8_STAGE(bufoff, gbase, voff) do { _Pragma("unroll") for (int _i = 0; _i < 2; ++_i) \
        __builtin_amdgcn_global_load_lds((const unsigned*)((const char*)(gbase) + (voff)[_i]), (PG8_LAS unsigned*)(lds + (bufoff) + ldsw + _i * 8192), 16, 0, 0); } while (0)
#define PG8_LDA(dst, b, h) do { _Pragma("unroll") for (int m = 0; m < 4; ++m) _Pragma("unroll") for (int k = 0; k < 2; ++k) dst[m][k] = *(const PG8_LAS bf16x8*)(lds + PG8_SA(b, h) + aoff + m * 2048 + k * 1024); } while (0)
#define PG8_LDB(dst, b, h) do { _Pragma("unroll") for (int n = 0; n < 2; ++n) _Pragma("unroll") for (int k = 0; k < 2; ++k) dst[n][k] = *(const PG8_LAS bf16x8*)(lds + PG8_SB(b, h) + boff + n * 2048 + k * 1024); } while (0)
#define PG8_MMA(ai, bj, At, Bt) do { __builtin_amdgcn_s_setprio(1); _Pragma("unroll") for (int m = 0; m < 4; ++m) _Pragma("unroll") for (int n = 0; n < 2; ++n) _Pragma("unroll") for (int k = 0; k < 2; ++k) \
        acc[ai][bj][m][n] = Mma<Epi::I8>::run(Bt[n][k], At[m][k], acc[ai][bj][m][n]); __builtin_amdgcn_s_setprio(0); } while (0)
#define PG8_MMA0(ai, bj, At, Bt) do { __builtin_amdgcn_s_setprio(1); _Pragma("unroll") for (int m = 0; m < 4; ++m) _Pragma("unroll") for (int n = 0; n < 2; ++n) { \
        acc[ai][bj][m][n] = Mma<Epi::I8>::run(Bt[n][0], At[m][0], acc_zero); acc[ai][bj][m][n] = Mma<Epi::I8>::run(Bt[n][1], At[m][1], acc[ai][bj][m][n]); } __builtin_amdgcn_s_setprio(0); } while (0)
#define PG8_WAIT_V(n) asm volatile("s_waitcnt vmcnt(" #n ")" ::: "memory")
#define PG8_WAIT_L(n) asm volatile("s_waitcnt lgkmcnt(" #n ")" ::: "memory")
#define PG8_BAR __builtin_amdgcn_s_barrier()
#define PG8_SCHED __builtin_amdgcn_sched_barrier(0)
    Unit cur, nxt; int ui = 0;
    if (!S.next(0, cur)) return;
    typedef typename Mma<Epi::I8>::acc_t acc_t; const acc_t acc_zero = {};
    acc_t acc[2][2][4][2];
    if constexpr (!SP2) {
#pragma unroll
    for (int a = 0; a < 2; ++a)
#pragma unroll
        for (int b = 0; b < 2; ++b)
#pragma unroll
            for (int m = 0; m < 4; ++m)
#pragma unroll
                for (int n = 0; n < 2; ++n) acc[a][b][m][n] = acc_zero;
    }
    bf16x8 At[4][2], B0[2][2], B1[2][2];
    const char* cA = (const char*)g.A + (size_t)cur.pm * tstep + cur.koff; const char* cB = (const char*)g.Bt + (size_t)cur.pb * tstep + cur.koff;
    S.a_ready(cur);
    if constexpr (SP2) {
        PG8_STAGE(PG8_SB(0, 0), cB, voffB); PG8_STAGE(PG8_SB(0, 1), cB + hstep, voffB); PG8_STAGE(PG8_SA(0, 0), cA, voffA); PG8_STAGE(PG8_SA(0, 1), cA + hstep, voffA);
        if (wr == 1) PG8_BAR;
        PG8_WAIT_V(2); PG8_BAR;
        PG8_STAGE(PG8_SB(1, 0), cB + kstep, voffB); PG8_STAGE(PG8_SA(1, 0), cA + kstep, voffA); PG8_STAGE(PG8_SB(1, 1), cB + hstep + kstep, voffB); PG8_STAGE(PG8_SA(1, 1), cA + hstep + kstep, voffA);
        PG8_WAIT_V(0); PG8_BAR;
    } else {
        PG8_STAGE(PG8_SB(0, 0), cB, voffB); PG8_STAGE(PG8_SA(0, 0), cA, voffA); PG8_STAGE(PG8_SB(0, 1), cB + hstep, voffB); PG8_STAGE(PG8_SA(0, 1), cA + hstep, voffA);
        if (wr == 1) PG8_BAR;
        PG8_WAIT_V(4); PG8_BAR;
        PG8_STAGE(PG8_SB(1, 0), cB + kstep, voffB); PG8_STAGE(PG8_SA(1, 0), cA + kstep, voffA); PG8_STAGE(PG8_SB(1, 1), cB + hstep + kstep, voffB);
        PG8_WAIT_V(6); PG8_BAR;
    }
    for (;;) {
        const bool has_next = S.next(ui + 1, nxt);
        const char* nA = has_next ? (const char*)g.A + (size_t)nxt.pm * tstep + nxt.koff : cA; const char* nB = has_next ? (const char*)g.Bt + (size_t)nxt.pb * tstep + nxt.koff : cB;
        if constexpr (SP2) {
        { const int t = 0;
            if constexpr (Epi::NSC != 0) E.stage(cur, lds + STAGE_BYTES + 4096 + (ui & 1) * 2048, wid, lane_id_v());
            const bool last = false;
            const char* a1 = cA + (size_t)(t + 1) * kstep;
            const char* a2 = last ? nA : cA + (size_t)(t + 2) * kstep; const char* b2 = last ? nB : cB + (size_t)(t + 2) * kstep;
            const char* a3 = a2 + kstep; const char* b3 = b2 + kstep;
            if (last && has_next) S.a_ready(nxt);
#define PG8_WV1 asm volatile("s_waitcnt vmcnt(%0)" :: "n"(Epi::NST + Epi::NSC + (Epi::DRAINS ? 0 : 8)) : "memory")
#define PG8_WV2 asm volatile("s_waitcnt vmcnt(%0)" :: "n"(Epi::NST + Epi::NSC + (Epi::DRAINS ? 6 : 8)) : "memory")
#define PG8_WV3 asm volatile("s_waitcnt vmcnt(%0)" :: "n"(Epi::NST + Epi::NSC + 8) : "memory")
            PG8_LDB(B0, 0, 0); PG8_LDB(B1, 0, 1); PG8_SCHED; PG8_LDA(At, 0, 0);
            PG8_WV1;
            PG8_WAIT_L(0); PG8_BAR; PG8_MMA0(0, 0, At, B0); PG8_MMA0(0, 1, At, B1); PG8_BAR; PG8_SCHED; (void)a1;
            PG8_LDA(At, 0, 1); PG8_STAGE(PG8_SB(0, 0), b2, voffB); PG8_STAGE(PG8_SB(0, 1), b2 + hstep, voffB); PG8_STAGE(PG8_SA(0, 0), a2, voffA);
            PG8_WV2;
            PG8_WAIT_L(0); PG8_BAR; PG8_MMA0(1, 0, At, B0); PG8_MMA0(1, 1, At, B1); PG8_BAR; PG8_SCHED;
            PG8_LDB(B0, 1, 0); PG8_LDB(B1, 1, 1); PG8_SCHED; PG8_LDA(At, 1, 0); PG8_STAGE(PG8_SA(0, 1), a2 + hstep, voffA);
            PG8_WV3; PG8_WAIT_L(0); PG8_BAR; PG8_MMA(0, 0, At, B0); PG8_MMA(0, 1, At, B1); PG8_BAR; PG8_SCHED;
            PG8_LDA(At, 1, 1); PG8_STAGE(PG8_SB(1, 0), b3, voffB); PG8_STAGE(PG8_SB(1, 1), b3 + hstep, voffB); PG8_STAGE(PG8_SA(1, 0), a3, voffA);
            PG8_WAIT_V(8); PG8_WAIT_L(0); PG8_BAR; PG8_MMA(1, 0, At, B0); PG8_MMA(1, 1, At, B1); PG8_SCHED;
#undef PG8_WV1
#undef PG8_WV2
#undef PG8_WV3
                }
        for (int t = 2; t < nt; t += 2) {
            PG8_BAR;
            const bool last = (t == nt - 2);
            const char* a1 = cA + (size_t)(t + 1) * kstep;
            const char* a2 = last ? nA : cA + (size_t)(t + 2) * kstep; const char* b2 = last ? nB : cB + (size_t)(t + 2) * kstep;
            const char* a3 = a2 + kstep; const char* b3 = b2 + kstep;
            if (last && has_next) S.a_ready(nxt);
#define PG8_WV1 PG8_WAIT_V(8)
#define PG8_WV2 PG8_WAIT_V(8)
            PG8_LDB(B0, 0, 0); PG8_LDB(B1, 0, 1); PG8_SCHED; PG8_LDA(At, 0, 0); PG8_STAGE(PG8_SA(1, 1), a1 + hstep, voffA);
            PG8_WV1;
            PG8_WAIT_L(0); PG8_BAR; PG8_MMA(0, 0, At, B0); PG8_MMA(0, 1, At, B1); PG8_BAR; PG8_SCHED;
            PG8_LDA(At, 0, 1); PG8_STAGE(PG8_SB(0, 0), b2, voffB); PG8_STAGE(PG8_SB(0, 1), b2 + hstep, voffB); PG8_STAGE(PG8_SA(0, 0), a2, voffA);
            PG8_WV2;
            PG8_WAIT_L(0); PG8_BAR; PG8_MMA(1, 0, At, B0); PG8_MMA(1, 1, At, B1); PG8_BAR; PG8_SCHED;
            PG8_LDB(B0, 1, 0); PG8_LDB(B1, 1, 1); PG8_SCHED; PG8_LDA(At, 1, 0); PG8_STAGE(PG8_SA(0, 1), a2 + hstep, voffA);
            PG8_WAIT_V(8); PG8_WAIT_L(0); PG8_BAR; PG8_MMA(0, 0, At, B0); PG8_MMA(0, 1, At, B1); PG8_BAR; PG8_SCHED;
            PG8_LDA(At, 1, 1); PG8_STAGE(PG8_SB(1, 0), b3, voffB); PG8_STAGE(PG8_SB(1, 1), b3 + hstep, voffB); PG8_STAGE(PG8_SA(1, 0), a3, voffA);
            PG8_WAIT_V(8); PG8_WAIT_L(0); PG8_BAR; PG8_MMA(1, 0, At, B0); PG8_MMA(1, 1, At, B1); PG8_SCHED;
#undef PG8_WV1
#undef PG8_WV2
                }
        } else {
        for (int t = 0; t < nt; t += 2) {
            const bool last = (t == nt - 2);
            const char* a1 = cA + (size_t)(t + 1) * kstep;
            const char* a2 = last ? nA : cA + (size_t)(t + 2) * kstep; const char* b2 = last ? nB : cB + (size_t)(t + 2) * kstep;
            const char* a3 = a2 + kstep; const char* b3 = b2 + kstep;
            if (last && has_next) S.a_ready(nxt);
            PG8_LDB(B0, 0, 0); PG8_SCHED; PG8_LDA(At, 0, 0); PG8_STAGE(PG8_SA(1, 1), a1 + hstep, voffA);
            PG8_WAIT_L(8); PG8_BAR; PG8_WAIT_L(0); PG8_MMA(0, 0, At, B0); PG8_BAR; PG8_SCHED;
            PG8_LDB(B1, 0, 1); PG8_STAGE(PG8_SB(0, 0), b2, voffB);
            PG8_BAR; PG8_WAIT_L(0); PG8_MMA(0, 1, At, B1); PG8_BAR;
            PG8_LDA(At, 0, 1); PG8_STAGE(PG8_SA(0, 0), a2, voffA);
            PG8_BAR; PG8_WAIT_L(0); PG8_MMA(1, 0, At, B0); PG8_BAR; PG8_SCHED;
            PG8_STAGE(PG8_SB(0, 1), b2 + hstep, voffB);
            PG8_WAIT_V(6); PG8_BAR; PG8_MMA(1, 1, At, B1); PG8_BAR;
            PG8_LDB(B0, 1, 0); PG8_SCHED; PG8_LDA(At, 1, 0); PG8_STAGE(PG8_SA(0, 1), a2 + hstep, voffA);
            PG8_WAIT_L(8); PG8_BAR; PG8_WAIT_L(0); PG8_MMA(0, 0, At, B0); PG8_BAR; PG8_SCHED;
            PG8_LDB(B1, 1, 1); PG8_STAGE(PG8_SB(1, 0), b3, voffB);
            PG8_BAR; PG8_WAIT_L(0); PG8_MMA(0, 1, At, B1); PG8_BAR;
            PG8_LDA(At, 1, 1); PG8_STAGE(PG8_SA(1, 0), a3, voffA);
            PG8_BAR; PG8_WAIT_L(0); PG8_MMA(1, 0, At, B0); PG8_BAR; PG8_SCHED;
            PG8_STAGE(PG8_SB(1, 1), b3 + hstep, voffB);
            PG8_WAIT_V(6); PG8_BAR; PG8_MMA(1, 1, At, B1); PG8_BAR;
        }
        }
        static_assert(!SP2 || ALIGN_EPI, "SP2 leaves the unit's last trailing barrier to the two statements around the epilogue");
        if constexpr (ALIGN_EPI) { if (wr == 0) PG8_BAR; }
        PG8_STAGE(PG8_SA(1, 1), nA + kstep + hstep, voffA);
        if constexpr (!Epi::AFTER_DRAIN) { const int l_ = lane_id_v(); E(acc, cur, wr, wc, l_ & 15, l_ >> 4, (const PG8_LAS float*)(lds + STAGE_BYTES + 4096 + (ui & 1) * 2048)); S.done(cur); }
        if (!has_next) break;
        if constexpr (!SP2) {
#pragma unroll
        for (int a = 0; a < 2; ++a)
#pragma unroll
            for (int b = 0; b < 2; ++b)
#pragma unroll
                for (int m = 0; m < 4; ++m)
#pragma unroll
                    for (int n = 0; n < 2; ++n) acc[a][b][m][n] = acc_zero;
        }
        cur = nxt; cA = nA; cB = nB; ++ui;
        if constexpr (ALIGN_EPI) { if (wr == 1) PG8_BAR; }
    }
    PG8_WAIT_V(0);
    if constexpr (!ALIGN_EPI) { if (wr == 0) PG8_BAR; }
    PG8_BAR;
    if constexpr (Epi::AFTER_DRAIN) { E.fused(acc, cur, wr, wc, fr, fq, lds, wid, lane); S.done(cur); }
#undef PG8_SA
#undef PG8_SB
#undef PG8_STAGE
#undef PG8_LDA
#undef PG8_LDB
#undef PG8_MMA
#undef PG8_WAIT_V
#undef PG8_WAIT_L
#undef PG8_BAR
#undef PG8_SCHED
}
}
namespace pg8 {
#define EPI_DRAIN() asm volatile("s_waitcnt vmcnt(0)" ::: "memory")
__device__ __forceinline__ void stage_scales(const float* lo_unit, const float* hi_unit, PG8_LAS unsigned char* buf, int wid, int lane) {
    const float* src = (wid < 4) ? lo_unit : hi_unit;
    __builtin_amdgcn_global_load_lds((const unsigned*)(src + (wid & 3) * 64 + lane), (PG8_LAS unsigned*)(buf + (wid >> 2) * 1024 + (wid & 3) * 256), 4, 0, 0);
}
template <bool I8> __device__ __forceinline__ f32x4 acc_f(const typename Mma<I8>::acc_t& a) { if constexpr (I8) return (f32x4){(float)a[0], (float)a[1], (float)a[2], (float)a[3]}; else return a; }
template <bool I8_, int LAY> struct EpiStore {
    static_assert(I8_, "scales from LDS: int8 form only");
    static constexpr bool PERM = true, AFTER_DRAIN = false, I8 = I8_, DRAINS = false; static constexpr int NST = 16, NSC = 1; typedef typename Mma<I8_>::acc_t acc_t;
    bf16_t* O; int ldc; const float* sa; const float* sw; float qscale;
    __device__ __forceinline__ void stage(const Unit& u, PG8_LAS unsigned char* buf, int wid, int lane) const { stage_scales(sw + u.pb * BM, sa + u.pm * BM, buf, wid, lane); }
    __device__ __forceinline__ void operator()(const acc_t (&acc)[2][2][4][2], const Unit& u, int wr, int wc, int fr, int fq, const PG8_LAS float* sc) const {
        const int row0 = u.pm * BM + wr * 64 + fr;
        f32x4 cs[2][2];
        if constexpr (I8) {
#pragma unroll
            for (int bj = 0; bj < 2; ++bj) { const PG8_LAS f32x4* p = (const PG8_LAS f32x4*)(sc + bj * HALF + wc * 32 + 8 * fq); cs[bj][0] = p[0]; cs[bj][1] = p[1]; } }
        float rsv[2][4];
#pragma unroll
        for (int ai = 0; ai < 2; ++ai)
#pragma unroll
            for (int m = 0; m < 4; ++m) { rsv[ai][m] = 1.f; if constexpr (I8) rsv[ai][m] = sc[256 + wr * 64 + fr + ai * HALF + m * 16]; }
        const int gj = u.pn >> 2, h0 = 4 * (u.pn & 3), b = u.pm >> 3;
        const int g = (LAY == 2) ? gj / 3 : 0, lg = (LAY == 2) ? 2 * g : 0;
        const float qs = (gj % 3 == 0) ? qscale : 1.f;
        bf16_t* const blk = O + ((size_t)(gj * 16 + b) * 16 + h0 + (wc >> 1)) * (2048 * 64) + (wc & 1) * 32 + 8 * fq;
#pragma unroll
        for (int ai = 0; ai < 2; ++ai)
#pragma unroll
            for (int m = 0; m < 4; ++m) { const int row = row0 + ai * HALF + m * 16, t = row & 2047, rp = ((t & ((1 << lg) - 1)) << (11 - lg)) + (t >> lg);
                const float rs = qs * rsv[ai][m];
#pragma unroll
                for (int bj = 0; bj < 2; ++bj) { f32x4 v0 = acc_f<I8>(acc[ai][bj][m][0]), v1 = acc_f<I8>(acc[ai][bj][m][1]);
                    if constexpr (I8) { v0 = v0 * cs[bj][0]; v1 = v1 * cs[bj][1]; }
                    v0 = v0 * rs; v1 = v1 * rs;
                    u32x4 w; w.x = cvt_pk_bf16(v0[0], v0[1]); w.y = cvt_pk_bf16(v0[2], v0[3]); w.z = cvt_pk_bf16(v1[0], v1[1]); w.w = cvt_pk_bf16(v1[2], v1[3]);
                    *(u32x4*)(blk + (size_t)bj * (2 * 2048 * 64) + (size_t)rp * 64) = w; } }
    }
};
template <bool I8_> struct EpiResid {
    static constexpr bool PERM = true, AFTER_DRAIN = false, I8 = I8_, DRAINS = true; static constexpr int NST = 16, NSC = 0; typedef typename Mma<I8_>::acc_t acc_t;
    bf16_t* H; int ldc; const float* sa; const float* sw;
    __device__ __forceinline__ void operator()(const acc_t (&acc)[2][2][4][2], const Unit& u, int wr, int wc, int fr, int fq, const PG8_LAS float* sc) const {
        const int row0 = u.pm * BM + wr * 64 + fr, col0 = u.pn * BM + wc * 32 + 8 * fq;
        f32x4 cs[2][2];
        if constexpr (I8) {
#pragma unroll
            for (int bj = 0; bj < 2; ++bj) { const f32x4* p = (const f32x4*)(sw + u.pb * BM + bj * HALF + wc * 32 + 8 * fq); cs[bj][0] = p[0]; cs[bj][1] = p[1]; } }
        float rsv[2][4];
#pragma unroll
        for (int ai = 0; ai < 2; ++ai)
#pragma unroll
            for (int m = 0; m < 4; ++m) { rsv[ai][m] = 1.f; if constexpr (I8) rsv[ai][m] = sa[row0 + ai * HALF + m * 16]; }
        EPI_DRAIN();
#pragma unroll
        for (int ai = 0; ai < 2; ++ai)
#pragma unroll
            for (int m = 0; m < 4; ++m) { const int row = row0 + ai * HALF + m * 16; bf16_t* rowp = H + (size_t)row * ldc + col0; const float rs = rsv[ai][m];
#pragma unroll
                for (int bj = 0; bj < 2; ++bj) { f32x4 v0 = acc_f<I8>(acc[ai][bj][m][0]), v1 = acc_f<I8>(acc[ai][bj][m][1]);
                    if constexpr (I8) { v0 = v0 * cs[bj][0] * rs; v1 = v1 * cs[bj][1] * rs; }
                    u32x4* hp = (u32x4*)(rowp + bj * HALF); const u32x4 o = *hp;
                    u32x4 w; w.x = cvt_pk_bf16(__uint_as_float(o.x << 16) + v0[0], __uint_as_float(o.x & 0xffff0000u) + v0[1]); w.y = cvt_pk_bf16(__uint_as_float(o.y << 16) + v0[2], __uint_as_float(o.y & 0xffff0000u) + v0[3]);
                    w.z = cvt_pk_bf16(__uint_as_float(o.z << 16) + v1[0], __uint_as_float(o.z & 0xffff0000u) + v1[1]); w.w = cvt_pk_bf16(__uint_as_float(o.w << 16) + v1[2], __uint_as_float(o.w & 0xffff0000u) + v1[3]);
                    *hp = w; } }
    }
};
template <bool I8_> struct EpiSwiGLU {
    static_assert(I8_, "scales from LDS: int8 form only");
    static constexpr bool PERM = true, AFTER_DRAIN = false, I8 = I8_, DRAINS = false; static constexpr int NST = 8, NSC = 1; typedef typename Mma<I8_>::acc_t acc_t;
    bf16_t* O; int ldc; const float* sa; const float* sw;
    __device__ __forceinline__ void stage(const Unit& u, PG8_LAS unsigned char* buf, int wid, int lane) const { stage_scales(sw + u.pb * BM, sa + u.pm * BM, buf, wid, lane); }
    static __device__ __forceinline__ float act(float g, float up) { return g * __builtin_amdgcn_rcpf(1.0f + __builtin_amdgcn_exp2f(-1.4426950408889634f * g)) * up; }
    __device__ __forceinline__ void operator()(const acc_t (&acc)[2][2][4][2], const Unit& u, int wr, int wc, int fr, int fq, const PG8_LAS float* sc) const {
        const int row0 = u.pm * BM + wr * 64 + fr, col0 = u.pn * HALF + wc * 32 + 8 * fq;
        f32x4 cs[2][2];
        if constexpr (I8) {
#pragma unroll
            for (int bj = 0; bj < 2; ++bj) { const PG8_LAS f32x4* p = (const PG8_LAS f32x4*)(sc + bj * HALF + wc * 32 + 8 * fq); cs[bj][0] = p[0]; cs[bj][1] = p[1]; } }
        float rsv[2][4];
#pragma unroll
        for (int ai = 0; ai < 2; ++ai)
#pragma unroll
            for (int m = 0; m < 4; ++m) { rsv[ai][m] = 1.f; if constexpr (I8) rsv[ai][m] = sc[256 + wr * 64 + fr + ai * HALF + m * 16]; }
#pragma unroll
        for (int ai = 0; ai < 2; ++ai)
#pragma unroll
            for (int m = 0; m < 4; ++m) { const int row = row0 + ai * HALF + m * 16; bf16_t* rowp = O + (size_t)row * ldc + col0; const float rs = rsv[ai][m];
                const float kr = -1.4426950408889634f * rs, rs2 = rs * rs;
                u32x4 w;
#pragma unroll
                for (int n = 0; n < 2; ++n) { const f32x4 ga = acc_f<I8>(acc[ai][0][m][n]), ua = acc_f<I8>(acc[ai][1][m][n]);
                    f32x4 A = ga, B = ua; if constexpr (I8) { A = ga * cs[0][n]; B = ua * cs[1][n]; }
                    const f32x4 targ = A * kr;
                    f32x4 tt; tt[0] = __builtin_amdgcn_exp2f(targ[0]); tt[1] = __builtin_amdgcn_exp2f(targ[1]); tt[2] = __builtin_amdgcn_exp2f(targ[2]); tt[3] = __builtin_amdgcn_exp2f(targ[3]);
                    const f32x4 dd = tt + 1.0f;
                    f32x4 rr; rr[0] = __builtin_amdgcn_rcpf(dd[0]); rr[1] = __builtin_amdgcn_rcpf(dd[1]); rr[2] = __builtin_amdgcn_rcpf(dd[2]); rr[3] = __builtin_amdgcn_rcpf(dd[3]);
                    const f32x4 o4 = (A * B) * (rr * rs2);
                    w[2 * n] = cvt_pk_bf16(o4[0], o4[1]); w[2 * n + 1] = cvt_pk_bf16(o4[2], o4[3]); }
                *(u32x4*)rowp = w; }
    }
};
struct EpiMoeDown {
    static constexpr bool PERM = true, AFTER_DRAIN = false, I8 = false, DRAINS = false; static constexpr int NST = 16, NSC = 1; typedef f32x4 acc_t;
    bf16_t* O; int ldc; const float* gate;
    __device__ __forceinline__ void stage(const Unit& u, PG8_LAS unsigned char* buf, int wid, int lane) const { stage_scales(gate + u.pm * BM, gate + u.pm * BM, buf, wid, lane); }
    __device__ __forceinline__ void operator()(const f32x4 (&acc)[2][2][4][2], const Unit& u, int wr, int wc, int fr, int fq, const PG8_LAS float* sc) const {
        const int row0 = u.pm * BM + wr * 64 + fr, col0 = u.pn * BM + wc * 32 + 8 * fq;
        float gtv[2][4];
#pragma unroll
        for (int ai = 0; ai < 2; ++ai)
#pragma unroll
            for (int m = 0; m < 4; ++m) gtv[ai][m] = sc[256 + wr * 64 + fr + ai * HALF + m * 16];
#pragma unroll
        for (int ai = 0; ai < 2; ++ai)
#pragma unroll
            for (int m = 0; m < 4; ++m) { const int row = row0 + ai * HALF + m * 16; const float gt = gtv[ai][m]; bf16_t* rowp = O + (size_t)row * ldc + col0;
#pragma unroll
                for (int bj = 0; bj < 2; ++bj) { const f32x4 v0 = acc[ai][bj][m][0] * gt, v1 = acc[ai][bj][m][1] * gt;
                    u32x4 w; w.x = cvt_pk_bf16(v0[0], v0[1]); w.y = cvt_pk_bf16(v0[2], v0[3]); w.z = cvt_pk_bf16(v1[0], v1[1]); w.w = cvt_pk_bf16(v1[2], v1[3]);
                    *(u32x4*)(rowp + bj * HALF) = w; } }
    }
};
}
namespace att {
typedef float f32x16 __attribute__((ext_vector_type(16)));
typedef float f32x2v __attribute__((ext_vector_type(2)));
typedef __bf16 bf16x2v __attribute__((ext_vector_type(2)));
typedef short bf16x8 __attribute__((ext_vector_type(8)));
typedef unsigned u32x4 __attribute__((ext_vector_type(4)));
typedef unsigned u32x2 __attribute__((ext_vector_type(2)));
typedef unsigned short bf16;
#define ATT_LAS __attribute__((address_space(3)))
constexpr float LOG2E = 1.4426950408889634f, LN2 = 0.6931471805599453f;
constexpr float SB_CUT = 40.0f, SB_CUT2 = 40.0f * 1.4426950408889634f;
__device__ __forceinline__ int crow(int r, int hi) { return (r & 3) + 8 * (r >> 2) + 4 * hi; }
__device__ __forceinline__ unsigned cvtpk(float lo, float hi) { f32x2v v = {lo, hi}; bf16x2v b = __builtin_convertvector(v, bf16x2v); return __builtin_bit_cast(unsigned, b); }

__device__ __forceinline__ float xmax32(float v) { auto r = __builtin_amdgcn_permlane32_swap(__float_as_uint(v), __float_as_uint(v), false, false); return fmaxf(__uint_as_float(r[0]), __uint_as_float(r[1])); }
__device__ __forceinline__ float xsum32(float v) { auto r = __builtin_amdgcn_permlane32_swap(__float_as_uint(v), __float_as_uint(v), false, false); return __uint_as_float(r[0]) + __uint_as_float(r[1]); }
__device__ __forceinline__ void load_rowfrags(bf16x8 (&f)[4], const bf16* rowbase  , int hh) {
#pragma unroll
    for (int ks = 0; ks < 4; ++ks) f[ks] = *(const bf16x8*)(rowbase + ks * 16 + hh * 8);
}
__device__ __forceinline__ f32x16 qk_tile(const bf16x8 (&kf)[4], const bf16x8 (&qf)[4]) {
    f32x16 s = {};
#pragma unroll
    for (int ks = 0; ks < 4; ++ks) s = __builtin_amdgcn_mfma_f32_32x32x16_bf16(kf[ks], qf[ks], s, 0, 0, 0);
    return s;
}
constexpr int VT_HALF = 2048;
constexpr int VT_BYTES = 2 * VT_HALF;
typedef short v4i16_t __attribute__((ext_vector_type(4)));
__device__ __forceinline__ u32x2 vtr(const ATT_LAS unsigned char* p) { return __builtin_bit_cast(u32x2, __builtin_amdgcn_ds_read_tr16_b64_v4i16((ATT_LAS v4i16_t*)p)); }
__device__ __forceinline__ void pv_tile(f32x16 (&o)[2], const f32x16& p, const ATT_LAS unsigned char* vt, int lane) {
    const int hh = lane >> 5, i16 = lane & 15;
    bf16x8 pb[2];
#pragma unroll
    for (int s = 0; s < 2; ++s) { u32x4 w; w.x = cvtpk(p[8 * s + 0], p[8 * s + 1]); w.y = cvtpk(p[8 * s + 2], p[8 * s + 3]); w.z = cvtpk(p[8 * s + 4], p[8 * s + 5]); w.w = cvtpk(p[8 * s + 6], p[8 * s + 7]); pb[s] = __builtin_bit_cast(bf16x8, w); }
    const ATT_LAS unsigned char* rb = vt + (4 * hh + (i16 >> 2)) * 64 + ((lane >> 4) & 1) * 32 + (i16 & 3) * 8;
#pragma unroll
    for (int db = 0; db < 2; ++db)
#pragma unroll
        for (int s = 0; s < 2; ++s) {
            const u32x2 lo = vtr(rb + db * VT_HALF + (16 * s) * 64), hi = vtr(rb + db * VT_HALF + (16 * s + 8) * 64);
            u32x4 a; a.x = lo.x; a.y = lo.y; a.z = hi.x; a.w = hi.y;
            o[db] = __builtin_amdgcn_mfma_f32_32x32x16_bf16(__builtin_bit_cast(bf16x8, a), pb[s], o[db], 0, 0, 0);
        }
}
__device__ __forceinline__ void pv_load(u32x2 (&vr)[2][2][2], const ATT_LAS unsigned char* vt, int lane) {
    const int hh = lane >> 5, i16 = lane & 15;
    const ATT_LAS unsigned char* rb = vt + (4 * hh + (i16 >> 2)) * 64 + ((lane >> 4) & 1) * 32 + (i16 & 3) * 8;
#pragma unroll
    for (int db = 0; db < 2; ++db)
#pragma unroll
        for (int s = 0; s < 2; ++s) { vr[db][s][0] = vtr(rb + db * VT_HALF + (16 * s) * 64); vr[db][s][1] = vtr(rb + db * VT_HALF + (16 * s + 8) * 64); }
}
__device__ __forceinline__ void pv_mma(f32x16 (&o)[2], const f32x16& p, const u32x2 (&vr)[2][2][2]) {
    bf16x8 pb[2];
#pragma unroll
    for (int s = 0; s < 2; ++s) { u32x4 w; w.x = cvtpk(p[8 * s + 0], p[8 * s + 1]); w.y = cvtpk(p[8 * s + 2], p[8 * s + 3]); w.z = cvtpk(p[8 * s + 4], p[8 * s + 5]); w.w = cvtpk(p[8 * s + 6], p[8 * s + 7]); pb[s] = __builtin_bit_cast(bf16x8, w); }
#pragma unroll
    for (int db = 0; db < 2; ++db)
#pragma unroll
        for (int s = 0; s < 2; ++s) { u32x4 av; av.x = vr[db][s][0].x; av.y = vr[db][s][0].y; av.z = vr[db][s][1].x; av.w = vr[db][s][1].y;
            o[db] = __builtin_amdgcn_mfma_f32_32x32x16_bf16(__builtin_bit_cast(bf16x8, av), pb[s], o[db], 0, 0, 0); }
}
__device__ __forceinline__ void store_ot(bf16* orow  , const f32x16 (&o)[2], float scale, int hh) {
#pragma unroll
    for (int db = 0; db < 2; ++db)
#pragma unroll
        for (int q = 0; q < 4; q += 2) {
            unsigned ax = cvtpk(o[db][4 * q] * scale, o[db][4 * q + 1] * scale), ay = cvtpk(o[db][4 * q + 2] * scale, o[db][4 * q + 3] * scale);
            unsigned bx = cvtpk(o[db][4 * q + 4] * scale, o[db][4 * q + 5] * scale), by = cvtpk(o[db][4 * q + 6] * scale, o[db][4 * q + 7] * scale);
            { auto r = __builtin_amdgcn_permlane32_swap(ax, bx, false, false); ax = r[0]; bx = r[1]; }
            { auto r = __builtin_amdgcn_permlane32_swap(ay, by, false, false); ay = r[0]; by = r[1]; }
            u32x4 w; w.x = ax; w.y = ay; w.z = bx; w.w = by;
            *(u32x4*)(orow + db * 32 + 8 * (q + hh)) = w; }
}

template <int BIAS> __device__ __forceinline__ unsigned pack8x4q(float a, float b, float c, float d, float scale) {
    typedef float f2_ __attribute__((ext_vector_type(2)));
    const f2_ s2 = {scale, scale}, m2 = {12582912.0f + (float)BIAS, 12582912.0f + (float)BIAS};
    const f2_ p = __builtin_elementwise_fma((f2_){a, b}, s2, m2), q = __builtin_elementwise_fma((f2_){c, d}, s2, m2);
    return __builtin_amdgcn_perm(__float_as_uint(p.y), __float_as_uint(p.x), 0x0c0c0400u) | __builtin_amdgcn_perm(__float_as_uint(q.y), __float_as_uint(q.x), 0x04000c0cu);
}
__device__ __forceinline__ void store_ot8(unsigned char* orow  , const f32x16 (&o)[2], float scale, int hh) {
#pragma unroll
    for (int db = 0; db < 2; ++db) {
        unsigned dq[4];
#pragma unroll
        for (int q = 0; q < 4; ++q) dq[q] = pack8x4q<128>(o[db][4 * q], o[db][4 * q + 1], o[db][4 * q + 2], o[db][4 * q + 3], scale);
        u32x4 w;
        { auto r = __builtin_amdgcn_permlane32_swap(dq[0], dq[2], false, false); w.x = r[0]; w.y = r[1]; }
        { auto r = __builtin_amdgcn_permlane32_swap(dq[1], dq[3], false, false); w.z = r[0]; w.w = r[1]; }
        *(u32x4*)(orow + db * 32 + 16 * hh) = w; }
}

constexpr int KV_SLOT = 4096 + VT_BYTES;
#ifndef SB_TEST_TRUNC
#define SB_TEST_TRUNC 0
#endif
struct DilUnit { const bf16* qbase; int row0, nslots, smin, dil, g, bh; };
__device__ __forceinline__ DilUnit dil_unit(const bf16* qkv, int U) {
    constexpr size_t HB = (size_t)2048 * 64, JB = 256 * HB;
    DilUnit d; d.bh = U / 24; const int rem = U - d.bh * 24; d.g = rem >> 3; const int uu = rem & 7;
    d.qbase = qkv + (size_t)(d.g * 3) * JB + (size_t)d.bh * HB;
    if (d.g == 2) { d.dil = 16; d.row0 = uu * 256; d.nslots = 8; d.smin = 0; }
    else { d.dil = (d.g == 0) ? 1 : 4; const int res = (d.g == 0) ? 0 : (uu >> 1), c = (d.g == 0) ? uu : (uu & 1), L = 2048 / d.dil; d.row0 = res * L + 32 * (8 * c - 4); d.nslots = 12; d.smin = (c == 0) ? 4 : 0; }
    return d;
}
struct DilRegs { u32x4 kv[12]; bf16x8 q[4]; };
__device__ __forceinline__ void dil_wave(const DilUnit& d, int wave, int& qrow0, int& s_first, int& nst) {
    if (d.g == 2) { qrow0 = d.row0 + wave * 32; s_first = (wave >> 2) * 4; nst = (wave & 3) + 1; }
    else { qrow0 = d.row0 + 32 * (4 + wave); s_first = wave; nst = 5; if (s_first < d.smin) { nst -= d.smin - s_first; s_first = d.smin; } }
}
__device__ __forceinline__ void dil_issue(DilRegs& r, const DilUnit& d, int tid, int wave, int lane) {
    constexpr size_t JB = (size_t)256 * 2048 * 64;
    const int hs = tid >> 8, key = (tid & 255) >> 3, chunk = tid & 7;
#pragma unroll
    for (int i = 0; i < 12; ++i) { const int s = 2 * (i % 6) + hs;
        if (s >= d.smin && s < d.nslots) r.kv[i] = *(const u32x4*)(d.qbase + (i < 6 ? JB : 2 * JB) + (size_t)(d.row0 + 32 * s + key) * 64 + chunk * 8); }
    int qrow0, s_first, nst; dil_wave(d, wave, qrow0, s_first, nst);
    load_rowfrags(r.q, d.qbase + (size_t)(qrow0 + (lane & 31)) * 64, lane >> 5);
}
__device__ __forceinline__ void dil_write(ATT_LAS unsigned char* ring, const DilRegs& r, const DilUnit& d, int tid) {
    const int hs = tid >> 8, key = (tid & 255) >> 3, chunk = tid & 7;
#pragma unroll
    for (int i = 0; i < 12; ++i) { const int s = 2 * (i % 6) + hs;
        ATT_LAS unsigned char* p = ring + s * KV_SLOT + (i < 6 ? key * 128 + ((chunk ^ ((key >> 1) & 7)) * 16) : 4096 + (chunk >> 2) * VT_HALF + key * 64 + (chunk & 3) * 16);
        if (s >= d.smin && s < d.nslots) *(ATT_LAS u32x4*)p = r.kv[i]; }
}
struct Dil2Unit { const bf16* qbase; int rowc, c, dil, g, bh; };
__device__ __forceinline__ Dil2Unit dil2_unit(const bf16* qkv, int P, int e) {
    constexpr size_t HB = (size_t)2048 * 64, JB = 256 * HB;
    Dil2Unit d; d.bh = P / 3; d.g = P - 3 * d.bh;
    d.qbase = qkv + (size_t)(d.g * 3) * JB + (size_t)d.bh * HB;
    if (d.g == 0) { d.dil = 1; d.rowc = 0; d.c = e; }
    else if (d.g == 1) { d.dil = 4; d.rowc = (e >> 1) * 512; d.c = e & 1; }
    else { d.dil = 16; d.rowc = e * 256; d.c = 0; }
    return d;
}
struct Dil2Regs { u32x4 kv[8]; bf16x8 q[4]; };
__device__ __forceinline__ void dil2_issue(Dil2Regs& r, const Dil2Unit& d, int tid, int wave, int lane) {
    constexpr size_t JB = (size_t)256 * 2048 * 64;
    const int hs = tid >> 8, key = (tid & 255) >> 3, chunk = tid & 7;
#pragma unroll
    for (int i = 0; i < 8; ++i) { const int sl = 2 * (i & 3) + hs;
        r.kv[i] = *(const u32x4*)(d.qbase + (i < 4 ? JB : 2 * JB) + (size_t)(d.rowc + 32 * (8 * d.c + sl) + key) * 64 + chunk * 8); }
    load_rowfrags(r.q, d.qbase + (size_t)(d.rowc + 32 * (8 * d.c + wave) + (lane & 31)) * 64, lane >> 5);
}
__device__ __forceinline__ void dil2_write(ATT_LAS unsigned char* ring, const Dil2Regs& r, const Dil2Unit& d, int tid) {
    const int hs = tid >> 8, key = (tid & 255) >> 3, chunk = tid & 7;
#pragma unroll
    for (int i = 0; i < 8; ++i) { const int sl = 2 * (i & 3) + hs, s = (8 * d.c + sl) & 15;
        ATT_LAS unsigned char* p = ring + s * KV_SLOT + (i < 4 ? key * 128 + ((chunk ^ ((key >> 1) & 7)) * 16) : 4096 + (chunk >> 2) * VT_HALF + key * 64 + (chunk & 3) * 16);
        *(ATT_LAS u32x4*)p = r.kv[i]; }
}
__device__ __forceinline__ void dil2_compute(const ATT_LAS unsigned char* ring, const Dil2Unit& d, const bf16x8 (&qf)[4], unsigned char* og_all, float* lse_all, float* osc_all, int wave, int lane) {
    const int r32 = lane & 31, hh = lane >> 5, h = d.bh & 15, b = d.bh >> 4;
    const int qt = (d.g == 2) ? (wave & 3) : 8 * d.c + wave, kt_lo = (qt - 4 < 0) ? 0 : qt - 4, sbase = (d.g == 2) ? 4 * (wave >> 2) : 0;
    const float slope2 = __builtin_amdgcn_exp2f(-0.5f * (float)(h + 1)) * (float)d.dil * LOG2E;
    float m = -1e30f, l = 0.f; f32x16 o[2]; o[0] = f32x16{}; o[1] = f32x16{};
    f32x16 cb;
#pragma unroll
    for (int r = 0; r < 16; ++r) cb[r] = slope2 * (float)crow(r, hh);
#define DIL2_QK(dst, kt_) do { const ATT_LAS unsigned char* sl_ = ring + ((sbase + (kt_)) & 15) * KV_SLOT; bf16x8 kf_[4]; \
        _Pragma("unroll") for (int ks = 0; ks < 4; ++ks) kf_[ks] = *(const ATT_LAS bf16x8*)(sl_ + r32 * 128 + (((2 * ks + hh) ^ ((r32 >> 1) & 7)) * 16)); \
        const float tb_ = -slope2 * (float)(32 * (qt - (kt_)) + r32); \
        dst = cb + tb_;     \
        __builtin_amdgcn_sched_barrier(0); \
        _Pragma("unroll") for (int ks = 0; ks < 4; ++ks) dst = __builtin_amdgcn_mfma_f32_32x32x16_bf16(kf_[ks], qf[ks], dst, 0, 0, 0); } while (0)
    f32x16 sn; DIL2_QK(sn, kt_lo);
    for (int kt = kt_lo; kt <= qt; ++kt) {
        const ATT_LAS unsigned char* slot = ring + ((sbase + kt) & 15) * KV_SLOT;
        f32x16 sc = sn;
        u32x2 vr[2][2][2]; pv_load(vr, slot + 4096, lane);
        if (kt < qt) DIL2_QK(sn, kt + 1);
        __builtin_amdgcn_sched_barrier(0);
        const bool edge = (kt == kt_lo) || (kt == qt);
        if (edge) {
            asm volatile("" ::: "memory");
            const int relb = 32 * (qt - kt) + r32;
#pragma unroll
            for (int r = 0; r < 16; ++r) { const int rel = relb - crow(r, hh); if (!((rel >= 0) && (rel <= 128))) sc[r] = -3.0e38f; }
        }
        float mt = -1e30f;
#pragma unroll
        for (int r = 0; r < 16; ++r) mt = fmaxf(mt, sc[r]);
        mt = xmax32(mt);
        const float mn = (mt - m > 8.0f) ? mt : m, alpha = __builtin_amdgcn_exp2f(m - mn); m = mn;
        { const float nmn = -mn; sc = sc + nmn; }
#pragma unroll
        for (int r = 0; r < 16; ++r) sc[r] = __builtin_amdgcn_exp2f(sc[r]);
        float ps;
        { typedef float f32x8v __attribute__((ext_vector_type(8))); typedef float f32x4v __attribute__((ext_vector_type(4)));
          const f32x8v s8 = __builtin_shufflevector(sc, sc, 0, 1, 2, 3, 4, 5, 6, 7) + __builtin_shufflevector(sc, sc, 8, 9, 10, 11, 12, 13, 14, 15);
          const f32x4v s4 = __builtin_shufflevector(s8, s8, 0, 1, 2, 3) + __builtin_shufflevector(s8, s8, 4, 5, 6, 7);
          const f32x2v s2 = __builtin_shufflevector(s4, s4, 0, 1) + __builtin_shufflevector(s4, s4, 2, 3);
          ps = s2.x + s2.y; }
        l = l * alpha + ps;
        if (__any(alpha != 1.0f)) {
#pragma unroll
            for (int r = 0; r < 16; ++r) { o[0][r] *= alpha; o[1][r] *= alpha; } }
        pv_mma(o, sc, vr);
    }
#undef DIL2_QK
    l = xsum32(l);
    const int rowp = d.rowc + 32 * ((d.g == 2) ? wave : qt) + r32, L = 2048 / d.dil, res = rowp / L, lsub = rowp - res * L;
    const size_t tok = (size_t)b * 2048 + (size_t)lsub * d.dil + res;
    float am = 0.f;
#pragma unroll
    for (int r = 0; r < 16; ++r) am = fmaxf(am, fmaxf(fabsf(o[0][r]), fabsf(o[1][r])));
    am = xmax32(am);
    store_ot8(og_all + ((size_t)(d.g * 256 + d.bh) * 2048 + rowp) * 64, o, am > 0.f ? 127.0f * __builtin_amdgcn_rcpf(am) : 0.f, hh);
    if (hh == 0) { const size_t ix = (size_t)d.g * (32768 * 16) + tok * 16 + h; lse_all[ix] = (m + __builtin_amdgcn_logf(l)) * LN2; osc_all[ix] = am * (1.0f / 127.0f) * __builtin_amdgcn_rcpf(l); }
}
__device__ __forceinline__ void dilated_phase2(const bf16* qkv, unsigned char* og_all, float* lse_all, float* osc_all, ATT_LAS unsigned char* ring, int vcu, int G, int tid, int wave, int lane) {
    constexpr int NP = 256 * 3;
    if (vcu >= NP) return;
    int P = vcu, e = 0;
    Dil2Regs r; Dil2Unit d = dil2_unit(qkv, P, e);
    dil2_issue(r, d, tid, wave, lane);
    for (;;) {
        dil2_write(ring, r, d, tid);
        bf16x8 qf[4];
#pragma unroll
        for (int ks = 0; ks < 4; ++ks) qf[ks] = r.q[ks];
        __syncthreads();
        int Pn = P, en = e + 1; if (en == 8) { en = 0; Pn = P + G; }
        const bool more = Pn < NP; const Dil2Unit dn = dil2_unit(qkv, more ? Pn : P, more ? en : e);
        if (more) dil2_issue(r, dn, tid, wave, lane);
        dil2_compute(ring, d, qf, og_all, lse_all, osc_all, wave, lane);
        __syncthreads();
        if (!more) break;
        P = Pn; e = en; d = dn;
    }
}

struct CombRow { u32x4 a, b, c; float l0, l1, l2, s0, s1, s2; };
__device__ __forceinline__ void comb_load(CombRow& r, const unsigned char* og_all, const float* lse_all, const float* osc_all, int m, int lane) {
    const size_t th = (size_t)m * 16 + (lane >> 2), G1 = (size_t)32768 * 16, E1 = (size_t)32768 * 1024;
    r.l0 = lse_all[th]; r.l1 = lse_all[G1 + th]; r.l2 = lse_all[2 * G1 + th];
    r.s0 = osc_all[th]; r.s1 = osc_all[G1 + th]; r.s2 = osc_all[2 * G1 + th];
    const int bb = m >> 11, tt = m & 2047, hd = lane >> 2;
    const unsigned char* p = og_all + ((size_t)(bb * 16 + hd) * 2048) * 64 + (lane & 3) * 16;
    r.a = *(const u32x4*)(p + (size_t)tt * 64);
    r.b = *(const u32x4*)(p + E1 + (size_t)(((tt & 3) << 9) + (tt >> 2)) * 64);
    r.c = *(const u32x4*)(p + 2 * E1 + (size_t)(((tt & 15) << 7) + (tt >> 4)) * 64);
}
__device__ __forceinline__ void comb_finish(const CombRow& r, unsigned char* y8, float* sa, int m, int lane) {
    const float mx = fmaxf(r.l0, fmaxf(r.l1, r.l2)), e0 = __expf(r.l0 - mx), e1 = __expf(r.l1 - mx), e2 = __expf(r.l2 - mx), inv = __builtin_amdgcn_rcpf(e0 + e1 + e2);
    float kn = -128.0f; asm volatile("" : "+v"(kn));
    const float w0 = e0 * inv * r.s0, w1 = e1 * inv * r.s1, w2 = e2 * inv * r.s2, c0 = kn * (w0 + w1 + w2);
    float y[16]; float am = 0.f;
    { typedef float f2_ __attribute__((ext_vector_type(2)));
      const f2_ w0v = {w0, w0}, w1v = {w1, w1}, w2v = {w2, w2}, c0v = {c0, c0};
#pragma unroll
      for (int k = 0; k < 4; ++k)
#pragma unroll
        for (int j = 0; j < 4; j += 2) {
            const f2_ a2 = {(float)((r.a[k] >> (8 * j)) & 0xffu), (float)((r.a[k] >> (8 * j + 8)) & 0xffu)}, b2 = {(float)((r.b[k] >> (8 * j)) & 0xffu), (float)((r.b[k] >> (8 * j + 8)) & 0xffu)},
                      c2 = {(float)((r.c[k] >> (8 * j)) & 0xffu), (float)((r.c[k] >> (8 * j + 8)) & 0xffu)};
            const f2_ v = __builtin_elementwise_fma(w0v, a2, __builtin_elementwise_fma(w1v, b2, __builtin_elementwise_fma(w2v, c2, c0v)));
            y[4 * k + j] = v.x; y[4 * k + j + 1] = v.y; am = fmaxf(am, fmaxf(fabsf(v.x), fabsf(v.y))); } }
    am = wave_max(am);
    const float q = am > 0.f ? 127.0f * __builtin_amdgcn_rcpf(am) : 0.f;
    u32x4 out;
#pragma unroll
    for (int k = 0; k < 4; ++k) out[k] = pack8x4q<0>(y[4 * k], y[4 * k + 1], y[4 * k + 2], y[4 * k + 3], q);
    *(u32x4*)(y8 + (size_t)m * 1024 + lane * 16) = out;
    if (lane == 0) sa[m] = am * (1.0f / (127.0f * 127.0f));
}
__device__ __forceinline__ void dilated_combine_2rows(const unsigned char* og_all, const float* lse_all, const float* osc_all, unsigned char* y8, float* sa, int m0, int m1, int lane) {
    const bool two = m1 < 32768;
    CombRow ra, rb; comb_load(ra, og_all, lse_all, osc_all, m0, lane); comb_load(rb, og_all, lse_all, osc_all, two ? m1 : m0, lane);
    comb_finish(ra, y8, sa, m0, lane);
    if (two) comb_finish(rb, y8, sa, m1, lane);
}

__device__ __forceinline__ DilUnit sb_unit(const bf16* qkv, int bh, int sub) {
    DilUnit d; d.bh = bh; d.g = 0; d.dil = 1; d.qbase = qkv + (size_t)bh * ((size_t)2048 * 64); d.row0 = 32 * (8 * sub - 4); d.nslots = 12; d.smin = (sub == 0) ? 4 : 0; return d;
}
constexpr float SB_CUTP = 4.2483542552915889e-18f;
template <bool DIAG> __device__ __forceinline__ void sb_math(float& Rp, f32x16& z, int lane) {
    const int r32 = lane & 31, hh = lane >> 5;
    f32x16 e2, om;
#pragma unroll
    for (int r = 0; r < 16; ++r) e2[r] = __builtin_amdgcn_exp2f(z[r]);
    const f32x16 dd = e2 + 1.0f;
#pragma unroll
    for (int r = 0; r < 16; ++r) om[r] = __builtin_amdgcn_rcpf(dd[r]);
    f32x16 be; { const f32x16 nom = -om; be = nom + 1.0f; }
    if (DIAG) {
#pragma unroll
        for (int r = 0; r < 16; ++r) { const bool valid = crow(r, hh) < r32; om[r] = valid ? om[r] : 1.0f; be[r] = valid ? be[r] : 0.f; } }
    float glo[4], ghi[4];
#pragma unroll
    for (int i = 0; i < 4; ++i) { const float g = (om[4 * i] * om[4 * i + 1]) * (om[4 * i + 2] * om[4 * i + 3]);
        auto r = __builtin_amdgcn_permlane32_swap(__float_as_uint(g), __float_as_uint(g), false, false); glo[i] = __uint_as_float(r[0]); ghi[i] = __uint_as_float(r[1]); }
    float qq = Rp;
#pragma unroll
    for (int i = 3; i >= 0; --i) {
        const float c3 = (hh == 0) ? qq * ghi[i] : qq;
        const float c2 = c3 * om[4 * i + 3], c1 = c2 * om[4 * i + 2], c0 = c1 * om[4 * i + 1];
        z[4 * i] = be[4 * i] * c0; z[4 * i + 1] = be[4 * i + 1] * c1; z[4 * i + 2] = be[4 * i + 2] * c2; z[4 * i + 3] = be[4 * i + 3] * c3;
        qq *= glo[i] * ghi[i];
    }
    Rp = qq;
}
__device__ __forceinline__ void sb_compute(const ATT_LAS unsigned char* ring, const DilUnit& d, int sub, const bf16x8 (&qf)[4], bf16* y, int wave, int lane) {
    const int r32 = lane & 31, hh = lane >> 5, h = d.bh & 15, b = d.bh >> 4, qt = 8 * sub + wave;
    float R = 1.0f; f32x16 o[2]; o[0] = f32x16{}; o[1] = f32x16{};
    bool done = false;
    { const ATT_LAS unsigned char* slot = ring + (wave + 4) * KV_SLOT;
        bf16x8 kf[4];
#pragma unroll
        for (int ks = 0; ks < 4; ++ks) kf[ks] = *(const ATT_LAS bf16x8*)(slot + r32 * 128 + (((2 * ks + hh) ^ ((r32 >> 1) & 7)) * 16));
        f32x16 z = qk_tile(kf, qf);
        sb_math<true>(R, z, lane);
        pv_tile(o, z, slot + 4096, lane);
        done = __all(R < SB_CUTP); }
    int kt_next = qt - 1;
    if (!done) for (int s = wave + 3; s >= d.smin + SB_TEST_TRUNC; --s) {
        const ATT_LAS unsigned char* slot = ring + s * KV_SLOT;
        bf16x8 kf[4];
#pragma unroll
        for (int ks = 0; ks < 4; ++ks) kf[ks] = *(const ATT_LAS bf16x8*)(slot + r32 * 128 + (((2 * ks + hh) ^ ((r32 >> 1) & 7)) * 16));
        f32x16 z = qk_tile(kf, qf);
        sb_math<false>(R, z, lane);
        pv_tile(o, z, slot + 4096, lane);
        kt_next = 8 * sub - 4 + s - 1;
        if (__all(R < SB_CUTP)) { done = true; break; }
    }
    if (!done && kt_next >= 0) {
        constexpr size_t JB = (size_t)256 * 2048 * 64;
        for (int kt = kt_next; kt >= 0; --kt) {
            bf16x8 kf[4]; load_rowfrags(kf, d.qbase + JB + (size_t)(32 * kt + r32) * 64, hh);
            f32x16 z = qk_tile(kf, qf);
            sb_math<false>(R, z, lane);
            bf16x8 pb[2];
#pragma unroll
            for (int s = 0; s < 2; ++s) { u32x4 w; w.x = cvtpk(z[8 * s + 0], z[8 * s + 1]); w.y = cvtpk(z[8 * s + 2], z[8 * s + 3]); w.z = cvtpk(z[8 * s + 4], z[8 * s + 5]); w.w = cvtpk(z[8 * s + 6], z[8 * s + 7]); pb[s] = __builtin_bit_cast(bf16x8, w); }
            const bf16* vb = d.qbase + 2 * JB + (size_t)(32 * kt) * 64;
#pragma unroll
            for (int db = 0; db < 2; ++db)
#pragma unroll
                for (int s = 0; s < 2; ++s) { u32x4 a;
#pragma unroll
                    for (int j2 = 0; j2 < 4; ++j2) { const int k0 = 16 * s + 8 * ((2 * j2) >> 2) + 4 * hh + ((2 * j2) & 3), k1 = k0 + 1;
                        a[j2] = (unsigned)vb[(size_t)k0 * 64 + db * 32 + r32] | ((unsigned)vb[(size_t)k1 * 64 + db * 32 + r32] << 16); }
                    o[db] = __builtin_amdgcn_mfma_f32_32x32x16_bf16(__builtin_bit_cast(bf16x8, a), pb[s], o[db], 0, 0, 0); }
            if (__all(R < SB_CUTP)) break;
        }
    }
    store_ot(y + ((size_t)b * 2048 + 32 * qt + r32) * 1024 + h * 64, o, 1.0f, hh);
}
__device__ __forceinline__ void sb_phase(const bf16* qkv, bf16* y, ATT_LAS unsigned char* ring, int vcu, int G, int tid, int wave, int lane) {
    int k = 0; if (vcu >= 2048) return;
    int U = vcu, sub = (U & 7);
    DilRegs r; DilUnit d = sb_unit(qkv, U >> 3, sub);
    dil_issue(r, d, tid, wave, lane);
    for (;;) {
        dil_write(ring, r, d, tid);
        bf16x8 qf[4];
#pragma unroll
        for (int ks = 0; ks < 4; ++ks) qf[ks] = r.q[ks];
        __syncthreads();
        const int Un = U + G, kn = k + 1, subn = ((Un & 7) + kn) & 7; const DilUnit dn = sb_unit(qkv, (Un < 2048 ? Un : U) >> 3, subn);
        if (Un < 2048) dil_issue(r, dn, tid, wave, lane);
        sb_compute(ring, d, sub, qf, y, wave, lane);
        __syncthreads();
        if (Un >= 2048) break;
        U = Un; k = kn; sub = subn; d = dn;
    }
}
}
#include <hip/hip_bf16.h>
#include <cmath>
constexpr int DM = 1024, NBATCH = 16, SEQ = 2048, MTOK = NBATCH * SEQ, NHEAD = 16, FF = 3584, NEXP = 8;
constexpr int NQKV_D = 9216, NQKV_S = 3072, NGU = 2 * FF;
constexpr int MP_MAX = 2 * MTOK + NEXP * 256;
constexpr float RMS_EPS = 1e-6f;
constexpr int NWAVES = 8;
constexpr size_t MiB = 1u << 20;
constexpr size_t WS_CTL = 0, WS_CMAX = 1 * MiB, CTL_ZERO_BYTES = 64 * 1024;
constexpr size_t WS_RE = 2 * MiB, WS_RW1 = WS_RE + 128 * 1024, WS_RW2 = WS_RW1 + 128 * 1024, WS_POS1 = WS_RW2 + 128 * 1024, WS_POS2 = WS_POS1 + 128 * 1024,
                 WS_GATE = WS_POS2 + 128 * 1024  , WS_CNT = WS_GATE + 512 * 1024  , WS_PTAB = WS_CNT + 16 * 1024  ,
                 WS_SAHN = WS_PTAB + 16 * 1024  , WS_SAY = WS_SAHN + 128 * 1024  , WS_SAHNS = WS_SAY + 128 * 1024  ;
static_assert(WS_SAHNS + 512 * 1024 <= 6 * MiB, "routing / scale arrays");
constexpr size_t WS_W = 6 * MiB;
constexpr size_t W8_IN = 0, W8_OUT = W8_IN + (size_t)2 * NQKV_D * DM, W8_SQKV = W8_OUT + (size_t)2 * DM * DM, W8_FGU = W8_SQKV + (size_t)2 * NQKV_S * DM, W8_MGU = W8_FGU + (size_t)2 * NGU * DM,
                 W_SOUT = W8_MGU + (size_t)16 * NGU * DM, W_FDN = W_SOUT + (size_t)2 * DM * DM * 2, W_MDN = W_FDN + (size_t)2 * DM * FF * 2, W_END = W_MDN + (size_t)16 * DM * FF * 2;
static_assert(W_END == 295698432, "weight bytes");
constexpr int C_IN = 0, C_OUT = C_IN + 2 * NQKV_D, C_SQKV = C_OUT + 2 * DM, C_FGU = C_SQKV + 2 * NQKV_S, C_MGU = C_FGU + 2 * NGU, C_END = C_MGU + 16 * NGU;
static_assert((size_t)C_END * 4 <= 1 * MiB, "absmax words");
constexpr size_t WS_H = 288 * MiB, WS_HN8 = 416 * MiB, WS_Y = 448 * MiB, WS_BIG = 512 * MiB, WS_S = 1088 * MiB, WS_END = 1352 * MiB;
static_assert(WS_W + W_END <= WS_H, "weights fit");
constexpr size_t S_OG = 0, S_LSE = 192 * MiB, S_OSC = 200 * MiB, S_HNS = 0, S_YS = 66 * MiB;
static_assert((size_t)MP_MAX * DM == 66 * MiB && (size_t)MTOK * NQKV_D * 2 == 576 * MiB && (size_t)MP_MAX * FF * 2 <= 576 * MiB && S_YS + (size_t)MP_MAX * DM * 2 <= 264 * MiB, "buffer sizes");
constexpr int CW_TMO = 0, CW_BAR = 4096;
static_assert((size_t)(CW_BAR + 3456) * 4 <= CTL_ZERO_BYTES, "the grid barrier's words lie inside the per-call memset");
constexpr float QMAX = 127.0f, INV_Q2 = 1.0f / (127.0f * 127.0f);

constexpr int RING_OFF = 0, RING_BYTES = 131072;
constexpr int LDSCTL_OFF = RING_BYTES, MISC_OFF = LDSCTL_OFF + 320;
constexpr int LDS_BYTES = 147456;
static_assert(MISC_OFF + 128 <= LDS_BYTES, "LDS map");
#define GAS __attribute__((address_space(1)))
#define LAS __attribute__((address_space(3)))
typedef unsigned short bf16;
typedef unsigned v4u __attribute__((ext_vector_type(4)));
typedef float f32x4 __attribute__((ext_vector_type(4)));
typedef short bf16x8 __attribute__((ext_vector_type(8)));
typedef GAS unsigned gu32;
typedef GAS unsigned long long gu64;
#define RLX_AGENT __ATOMIC_RELAXED, __HIP_MEMORY_SCOPE_AGENT
#define LDS_WAIT() asm volatile("s_waitcnt lgkmcnt(0)" ::: "memory")
#define VM_WAIT() asm volatile("s_waitcnt vmcnt(0)" ::: "memory")
__device__ __forceinline__ unsigned long long rt() { return __builtin_amdgcn_s_memrealtime(); }
__device__ __forceinline__ unsigned f2bf(float f) { unsigned u = __builtin_bit_cast(unsigned, f); return (u + 0x7fffu + ((u >> 16) & 1u)) >> 16; }
__device__ __forceinline__ unsigned pk2(float lo, float hi) { return f2bf(lo) | (f2bf(hi) << 16); }

#define XB_TMO      128
#define XB_XCNT(j)  (256  + 64 * (j))
#define XB_XSUB(j)  (1280 + 64 * (j))
#define XB_XGEN(j)  (2304 + 64 * (j))
#define XB_TOP      3328
#define XB_TOPGEN   3392
#define XCD_BAR_WORDS 3456
#define XB_SPIN_CAP (1u << 18)

__device__ __forceinline__ unsigned xb_ld(unsigned* p)              { return __hip_atomic_load(p, __ATOMIC_RELAXED, __HIP_MEMORY_SCOPE_AGENT); }
__device__ __forceinline__ unsigned xb_add(unsigned* p, unsigned v) { return __hip_atomic_fetch_add(p, v, __ATOMIC_RELAXED, __HIP_MEMORY_SCOPE_AGENT); }
__device__ __forceinline__ unsigned xb_xcc_id() { return (unsigned)__builtin_amdgcn_s_getreg((3 << 11) | 20) & 0xFu; }
#define XB_SPIN(cond, bar) do { unsigned _sp = 0; while (cond) { __builtin_amdgcn_s_sleep(1); \
    if ((++_sp & 255u) == 0u) { if (xb_ld(&(bar)[XB_TMO])) break; if (_sp > XB_SPIN_CAP) { atomicAdd(&(bar)[XB_TMO], 1u); break; } } } } while (0)

struct XcdBarrier {
    unsigned* bar; unsigned x; int t0, wave_s;
    volatile LAS unsigned* st;
};

__device__ __forceinline__ XcdBarrier xcd_barrier_post(unsigned* bar, volatile LAS unsigned* st, int t0) {
    XcdBarrier b; b.bar = bar; b.x = xb_xcc_id(); b.st = st; b.t0 = t0; b.wave_s = 0;
    if (t0) (void)xb_add(&bar[XB_XCNT(b.x)], 1u);
    return b;
}
__device__ __forceinline__ void xcd_barrier_complete(unsigned* bar, unsigned x, unsigned& nloc, unsigned& nx) {
    const unsigned G = gridDim.x * gridDim.y * gridDim.z;
    unsigned sum, cnt, mine, sp = 0u;
    for (;;) {
        sum = 0u; cnt = 0u; mine = 0u;
#pragma unroll
        for (unsigned j = 0; j < 16; ++j) { const unsigned c = xb_ld(&bar[XB_XCNT(j)]); sum += c; cnt += (c > 0u) ? 1u : 0u; mine = (j == x) ? c : mine; }
        if (sum == G) break;
        __builtin_amdgcn_s_sleep(1);
        if ((++sp & 255u) == 0u) { if (xb_ld(&bar[XB_TMO])) break; if (sp > XB_SPIN_CAP) { atomicAdd(&bar[XB_TMO], 1u); break; } }
    }
    nloc = mine > 0u ? mine : 1u; nx = cnt > 0u ? cnt : 1u;
}

__device__ __forceinline__ void xcd_barrier(const XcdBarrier& b) {
    asm volatile("s_waitcnt vmcnt(0)" ::: "memory");
    __syncthreads();
    if (b.wave_s == 0 && lane_id_v() == 0) {
        unsigned* bar = b.bar;
        __builtin_amdgcn_s_waitcnt(0);
        unsigned nloc = b.st[0], nx = b.st[1];
        if (nloc == 0u) { xcd_barrier_complete(bar, b.x, nloc, nx); b.st[0] = nloc; b.st[1] = nx; }
        const unsigned old = xb_add(&bar[XB_XSUB(b.x)], 1u);
        const unsigned gen = old / nloc;
        if (old + 1u == (gen + 1u) * nloc) {
            __builtin_amdgcn_fence(__ATOMIC_RELEASE, "agent");
            asm volatile("s_waitcnt vmcnt(0)" ::: "memory");
            const unsigned og = xb_add(&bar[XB_TOP], 1u);
            const unsigned tg = og / nx;
            if (og + 1u == (tg + 1u) * nx) xb_add(&bar[XB_TOPGEN], 1u);
            else XB_SPIN(xb_ld(&bar[XB_TOPGEN]) == tg, bar);
            __builtin_amdgcn_fence(__ATOMIC_ACQUIRE, "agent");
            xb_add(&bar[XB_XGEN(b.x)], 1u);
            asm volatile("s_waitcnt vmcnt(0)" ::: "memory");
        } else {
            XB_SPIN(xb_ld(&bar[XB_XGEN(b.x)]) == gen, bar);
            __builtin_amdgcn_fence(__ATOMIC_ACQUIRE, "agent");
            asm volatile("s_waitcnt vmcnt(0)" ::: "memory");
        }
    }
    __syncthreads();
}
struct Frame {
    LAS unsigned char* lds;
    volatile LAS unsigned* MISC;
    gu32* ctl;
    int tid, lane, wave;
    int vcu, G, bx;
};
__device__ __forceinline__ unsigned pack_i8x4(float a, float b, float c, float d) {
    const int ia = (int)rintf(a), ib = (int)rintf(b), ic = (int)rintf(c), id = (int)rintf(d);
    return (unsigned)(ia & 0xff) | ((unsigned)(ib & 0xff) << 8) | ((unsigned)(ic & 0xff) << 16) | ((unsigned)(id & 0xff) << 24);
}
template <int BIAS> __device__ __forceinline__ unsigned pack8x4q(float a, float b, float c, float d, float scale) {
    typedef float f2_ __attribute__((ext_vector_type(2)));
    const f2_ s2 = {scale, scale}, m2 = {12582912.0f + (float)BIAS, 12582912.0f + (float)BIAS};
    const f2_ p = __builtin_elementwise_fma((f2_){a, b}, s2, m2), q = __builtin_elementwise_fma((f2_){c, d}, s2, m2);
    return __builtin_amdgcn_perm(__float_as_uint(p.y), __float_as_uint(p.x), 0x0c0c0400u) | __builtin_amdgcn_perm(__float_as_uint(q.y), __float_as_uint(q.x), 0x04000c0cu);
}
__device__ __forceinline__ float bf_lo(unsigned w) { return __uint_as_float(w << 16); }
__device__ __forceinline__ float bf_hi(unsigned w) { return __uint_as_float(w & 0xffff0000u); }

__device__ __forceinline__ void transpose_item(const float* W, int K, int N, bf16* WT, int mode, LAS float* scr, int item, int lane) {
    const int nblk = N / 32, kb = item / nblk, nb = item % nblk, k0 = 64 * kb, n0 = 32 * nb;
    int drow0 = n0;
    if (mode == 1) { const int up = (n0 >= FF) ? 1 : 0, c = n0 - up * FF; drow0 = (c >> 7) * 256 + up * 128 + (c & 127); }
#pragma unroll 8
    for (int i = 0; i < 32; ++i) { const int kk = 2 * i + (lane >> 5); scr[kk * 33 + (lane & 31)] = __builtin_nontemporal_load(W + (size_t)(k0 + kk) * N + n0 + (lane & 31)); }
    LDS_WAIT(); asm volatile("" ::: "memory");
    const int c = lane & 7;
#pragma unroll
    for (int j = 0; j < 4; ++j) { const int n = (lane >> 3) + 8 * j; const LAS float* s = scr + (8 * c) * 33 + n;
        v4u o; o.x = pk2(s[0 * 33], s[1 * 33]); o.y = pk2(s[2 * 33], s[3 * 33]); o.z = pk2(s[4 * 33], s[5 * 33]); o.w = pk2(s[6 * 33], s[7 * 33]);
        *(GAS v4u*)(WT + (size_t)(drow0 + n) * K + k0 + 8 * c) = o; }
    LDS_WAIT(); asm volatile("" ::: "memory");
}
__device__ __forceinline__ void conv_family(Frame& F, const float* src, bf16* dst, int nmat, int K, int N, int mode, LAS float* scr) {
    const int gw = F.vcu * NWAVES + F.wave, NGW = F.G * NWAVES;
    const int ipm = (K / 64) * (N / 32), total = nmat * ipm;
    for (int it = gw; it < total; it += NGW) { const int mat = it / ipm, r = it - mat * ipm;
        transpose_item(src + (size_t)mat * K * N, K, N, dst + (size_t)mat * K * N, mode, scr, r, F.lane); }
}

__device__ __forceinline__ int dest_row(int n, int mode) { if (mode & 1) { const int up = (n >= FF) ? 1 : 0, c = n - up * FF; return (c >> 7) * 256 + up * 128 + (c & 127); } return n; }
__device__ __forceinline__ void absmax_family(Frame& F, const float* src, unsigned* cmax, int nmat, int K, int N, int mode) {
    const int gw = F.vcu * NWAVES + F.wave, NGW = F.G * NWAVES;
    const int nch = N / 256, ipm = (K / 64) * nch, total = nmat * ipm;
    for (int it = gw; it < total; it += NGW) { const int mat = it / ipm, r = it - mat * ipm, kc = r / nch, nc = r - kc * nch;
        const float* W = src + (size_t)mat * K * N + (size_t)(kc * 64) * N + nc * 256 + 4 * F.lane;
        f32x4 mx = {0.f, 0.f, 0.f, 0.f};
#pragma unroll 8
        for (int k = 0; k < 64; ++k) { const f32x4 w = *(const f32x4*)(W + (size_t)k * N); mx.x = fmaxf(mx.x, fabsf(w.x)); mx.y = fmaxf(mx.y, fabsf(w.y)); mx.z = fmaxf(mx.z, fabsf(w.z)); mx.w = fmaxf(mx.w, fabsf(w.w)); }
        unsigned* c = cmax + (size_t)mat * N + dest_row(nc * 256 + 4 * F.lane, mode);
        atomicMax(c + 0, __float_as_uint(mx.x)); atomicMax(c + 1, __float_as_uint(mx.y)); atomicMax(c + 2, __float_as_uint(mx.z)); atomicMax(c + 3, __float_as_uint(mx.w));
    }
}
__device__ __forceinline__ void quant_item(const float* W, int K, int N, unsigned char* WT, const unsigned* cmax, int mode, LAS float* scr, int item, int lane) {
    const int nblk = N / 32, kb = item / nblk, nb = item % nblk, k0 = 64 * kb, n0 = 32 * nb;
    const int drow0 = dest_row(n0, mode);
#pragma unroll 8
    for (int i = 0; i < 32; ++i) { const int kk = 2 * i + (lane >> 5); scr[kk * 33 + (lane & 31)] = W[(size_t)(k0 + kk) * N + n0 + (lane & 31)]; }
    LDS_WAIT(); asm volatile("" ::: "memory");
    const int c = lane & 7;
#pragma unroll
    for (int j = 0; j < 4; ++j) { const int n = (lane >> 3) + 8 * j; const LAS float* s = scr + (8 * c) * 33 + n;
        const float am = __uint_as_float(cmax[drow0 + n]), inv = am > 0.f ? QMAX / am : 0.f;
        const unsigned lo = pack8x4q<0>(s[0 * 33], s[1 * 33], s[2 * 33], s[3 * 33], inv), hi = pack8x4q<0>(s[4 * 33], s[5 * 33], s[6 * 33], s[7 * 33], inv);
        *(GAS unsigned long long*)(WT + (size_t)(drow0 + n) * K + k0 + 8 * c) = (unsigned long long)lo | ((unsigned long long)hi << 32); }
    LDS_WAIT(); asm volatile("" ::: "memory");
}
__device__ __forceinline__ void quant_family(Frame& F, const float* src, unsigned char* dst, const unsigned* cmax, int nmat, int K, int N, int mode, LAS float* scr) {
    const int gw = F.vcu * NWAVES + F.wave, NGW = F.G * NWAVES;
    const int ipm = (K / 64) * (N / 32), total = nmat * ipm;
    for (int it = gw; it < total; it += NGW) { const int mat = it / ipm, r = it - mat * ipm;
        quant_item(src + (size_t)mat * K * N, K, N, dst + (size_t)mat * K * N, cmax + (size_t)mat * N, mode, scr, r, F.lane); }
}

__device__ __forceinline__ void quant_strips(Frame& F, const float* src, unsigned char* dst, float* cmax, int nmat, int N, int mode) {
    constexpr int K = 1024;
    LAS float* T = (LAS float*)(F.lds + RING_OFF);
    LAS float* P = (LAS float*)(F.lds + LDSCTL_OFF + 1024);
    const int spm = N / 32, total = nmat * spm;
    const int n = F.tid & 31, kg = F.tid >> 5;
    for (int it = F.vcu; it < total; it += F.G) {
        const int mat = it / spm, n0 = 32 * (it - mat * spm);
        const float* W = src + (size_t)mat * K * N + n0 + (F.lane & 7) * 4;
#pragma unroll
        for (int j = 0; j < 16; ++j) { const int q = j * 8 + F.wave;
            __builtin_amdgcn_global_load_lds((const unsigned*)(W + (size_t)(8 * q + (F.lane >> 3)) * N), (LAS unsigned*)((LAS unsigned char*)T + q * 1024), 16, 0, 2); }
        asm volatile("s_waitcnt vmcnt(0)" ::: "memory");
        __syncthreads();
        float v[64]; float am = 0.f;
#pragma unroll
        for (int i = 0; i < 64; ++i) { v[i] = T[(kg * 64 + i) * 32 + n]; am = fmaxf(am, fabsf(v[i])); }
        P[kg * 32 + n] = am;
        __syncthreads();
        float cm = 0.f;
#pragma unroll
        for (int g = 0; g < 16; ++g) cm = fmaxf(cm, P[g * 32 + n]);
        const float inv = cm > 0.f ? QMAX / cm : 0.f;
        const int drow = dest_row(n0, mode) + n;
        unsigned char* o = dst + (size_t)mat * K * N + (size_t)drow * K + kg * 64;
#pragma unroll
        for (int c = 0; c < 4; ++c) { v4u w;
            w.x = pack8x4q<0>(v[16 * c + 0], v[16 * c + 1], v[16 * c + 2], v[16 * c + 3], inv); w.y = pack8x4q<0>(v[16 * c + 4], v[16 * c + 5], v[16 * c + 6], v[16 * c + 7], inv);
            w.z = pack8x4q<0>(v[16 * c + 8], v[16 * c + 9], v[16 * c + 10], v[16 * c + 11], inv); w.w = pack8x4q<0>(v[16 * c + 12], v[16 * c + 13], v[16 * c + 14], v[16 * c + 15], inv);
            *(GAS v4u*)(o + 16 * c) = w; }
        if (kg == 0) cmax[(size_t)mat * N + drow] = cm;
        __syncthreads();
    }
}

__device__ __forceinline__ void ld8_bf16(float (&v)[8], const bf16* p) { const v4u w = *(const v4u*)p;
#pragma unroll
    for (int k = 0; k < 4; ++k) { v[2 * k] = bf_lo(w[k]); v[2 * k + 1] = bf_hi(w[k]); } }
__device__ __forceinline__ void ld8_f32(float (&v)[8], const float* p) { const f32x4 a = *(const f32x4*)p, b = *(const f32x4*)(p + 4); v[0] = a.x; v[1] = a.y; v[2] = a.z; v[3] = a.w; v[4] = b.x; v[5] = b.y; v[6] = b.z; v[7] = b.w; }
__device__ __forceinline__ void st8_bf16(bf16* p, const float (&v)[8]) { v4u w; w.x = pk2(v[0], v[1]); w.y = pk2(v[2], v[3]); w.z = pk2(v[4], v[5]); w.w = pk2(v[6], v[7]); *(v4u*)p = w; }
template <int MODE>
__device__ __forceinline__ void norm_load(Frame& F, int m, float (&v)[2][8], const float* x, const bf16* h, const bf16* ys, const int* pos1, const int* pos2) {
#pragma unroll
    for (int j = 0; j < 2; ++j) { if (MODE == 0) ld8_f32(v[j], x + (size_t)m * DM + 512 * j + 8 * F.lane); else ld8_bf16(v[j], h + (size_t)m * DM + 512 * j + 8 * F.lane); }
    if (MODE == 2 || MODE == 3) {
        const int p1 = __hip_atomic_load(pos1 + m, __ATOMIC_RELAXED, __HIP_MEMORY_SCOPE_AGENT), p2 = __hip_atomic_load(pos2 + m, __ATOMIC_RELAXED, __HIP_MEMORY_SCOPE_AGENT);
#pragma unroll
        for (int j = 0; j < 2; ++j) { float a[8], b[8]; ld8_bf16(a, ys + (size_t)p1 * DM + 512 * j + 8 * F.lane); ld8_bf16(b, ys + (size_t)p2 * DM + 512 * j + 8 * F.lane);
#pragma unroll
            for (int k = 0; k < 8; ++k) v[j][k] += a[k] + b[k]; }
    }
}
template <int MODE>
__device__ __forceinline__ void norm_finish(Frame& F, int m, float (&v)[2][8], const float (&gn)[2][8], bf16* h, unsigned char* hn8, float* sa, float* out) {
    if (MODE == 0 || MODE == 2) {
#pragma unroll
        for (int j = 0; j < 2; ++j) st8_bf16(h + (size_t)m * DM + 512 * j + 8 * F.lane, v[j]); }
    float s2 = 0.f;
#pragma unroll
    for (int j = 0; j < 2; ++j)
#pragma unroll
        for (int k = 0; k < 8; ++k) s2 += v[j][k] * v[j][k];
    const float rstd = __builtin_amdgcn_rsqf(wave_sum(s2) * (1.f / DM) + RMS_EPS);
    if (MODE == 3) {
#pragma unroll
        for (int j = 0; j < 2; ++j) { f32x4* o = (f32x4*)(out + (size_t)m * DM + 512 * j + 8 * F.lane);
            o[0] = (f32x4){v[j][0] * rstd * gn[j][0], v[j][1] * rstd * gn[j][1], v[j][2] * rstd * gn[j][2], v[j][3] * rstd * gn[j][3]};
            o[1] = (f32x4){v[j][4] * rstd * gn[j][4], v[j][5] * rstd * gn[j][5], v[j][6] * rstd * gn[j][6], v[j][7] * rstd * gn[j][7]}; }
    } else {
        float am = 0.f;
#pragma unroll
        for (int j = 0; j < 2; ++j)
#pragma unroll
            for (int k = 0; k < 8; ++k) { v[j][k] = v[j][k] * rstd * gn[j][k]; am = fmaxf(am, fabsf(v[j][k])); }
        am = wave_max(am); const float inv = am > 0.f ? QMAX * __builtin_amdgcn_rcpf(am) : 0.f;
#pragma unroll
        for (int j = 0; j < 2; ++j) { const unsigned lo = pack8x4q<0>(v[j][0], v[j][1], v[j][2], v[j][3], inv), hi = pack8x4q<0>(v[j][4], v[j][5], v[j][6], v[j][7], inv);
            *(unsigned long long*)(hn8 + (size_t)m * DM + 512 * j + 8 * F.lane) = (unsigned long long)lo | ((unsigned long long)hi << 32); }
        if (F.lane == 0) sa[m] = am * INV_Q2; }
}
template <int MODE>
__device__ __forceinline__ void norm_rows(Frame& F, const float* x, bf16* h, unsigned char* hn8, float* sa, float* out, const float* gain, const bf16* ys, const int* pos1, const int* pos2) {
    const int gw = F.vcu * NWAVES + F.wave, NGW = F.G * NWAVES;
    float gn[2][8];
#pragma unroll
    for (int j = 0; j < 2; ++j) ld8_f32(gn[j], gain + 512 * j + 8 * F.lane);
    for (int m = gw; m < MTOK; m += 2 * NGW) {
        const int m1 = m + NGW; const bool two = m1 < MTOK;
        float va[2][8], vb[2][8];
        norm_load<MODE>(F, m, va, x, h, ys, pos1, pos2);
        norm_load<MODE>(F, two ? m1 : m, vb, x, h, ys, pos1, pos2);
        norm_finish<MODE>(F, m, va, gn, h, hn8, sa, out);
        if (two) norm_finish<MODE>(F, m1, vb, gn, h, hn8, sa, out);
    }
}

__device__ __forceinline__ void unpack8(float (&v)[8], const v4u w) {
#pragma unroll
    for (int k = 0; k < 4; ++k) { v[2 * k] = bf_lo(w[k]); v[2 * k + 1] = bf_hi(w[k]); } }
__device__ __forceinline__ float reduce8_butterfly(const float (&v)[8], int lane) {
    float w[4], x[2];
#pragma unroll
    for (int e = 0; e < 4; ++e) { auto r = __builtin_amdgcn_permlane32_swap(__float_as_uint(v[e]), __float_as_uint(v[e + 4]), false, false); w[e] = __uint_as_float(r[0]) + __uint_as_float(r[1]); }
#pragma unroll
    for (int e = 0; e < 2; ++e) { auto r = __builtin_amdgcn_permlane16_swap(__float_as_uint(w[e]), __float_as_uint(w[e + 2]), false, false); x[e] = __uint_as_float(r[0]) + __uint_as_float(r[1]); }
    const bool hi8 = (lane & 8) != 0;
    const float keep = hi8 ? x[1] : x[0], send = hi8 ? x[0] : x[1];
    float y = keep + dppf<0x128>(send);
    y += dppf<0xB1>(y); y += dppf<0x4E>(y); y += dppf<0x141>(y);
    return y;
}
__device__ __forceinline__ int router_pair(Frame& F, int m, int i, float (&va)[2][8], float (&vb)[2][8], const float (&gn)[2][8], unsigned char* hn8, const LAS f32x4* wl, float& ksa, int& kre, float& kw1, float& kw2) {
    float s2a = 0.f, s2b = 0.f;
#pragma unroll
    for (int j = 0; j < 2; ++j)
#pragma unroll
        for (int k = 0; k < 8; ++k) { s2a += va[j][k] * va[j][k]; s2b += vb[j][k] * vb[j][k]; }
    const float rstda = __builtin_amdgcn_rsqf(wave_sum(s2a) * (1.f / DM) + RMS_EPS), rstdb = __builtin_amdgcn_rsqf(wave_sum(s2b) * (1.f / DM) + RMS_EPS);
    float ama = 0.f, amb = 0.f;
#pragma unroll
    for (int j = 0; j < 2; ++j)
#pragma unroll
        for (int k = 0; k < 8; ++k) { va[j][k] = va[j][k] * rstda * gn[j][k]; ama = fmaxf(ama, fabsf(va[j][k])); vb[j][k] = vb[j][k] * rstdb * gn[j][k]; amb = fmaxf(amb, fabsf(vb[j][k])); }
    ama = wave_max(ama); amb = wave_max(amb);
    const float inva = ama > 0.f ? QMAX * __builtin_amdgcn_rcpf(ama) : 0.f, invb = amb > 0.f ? QMAX * __builtin_amdgcn_rcpf(amb) : 0.f;
    ksa = (F.lane == i) ? ama * INV_Q2 : ((F.lane == i + 1) ? amb * INV_Q2 : ksa);
    typedef float f2_ __attribute__((ext_vector_type(2)));
    f2_ la2[4] = {{0.f, 0.f}, {0.f, 0.f}, {0.f, 0.f}, {0.f, 0.f}}, lb2[4] = {{0.f, 0.f}, {0.f, 0.f}, {0.f, 0.f}, {0.f, 0.f}};
#pragma unroll
    for (int j = 0; j < 2; ++j) {
        { const unsigned lo = pack8x4q<0>(va[j][0], va[j][1], va[j][2], va[j][3], inva), hi = pack8x4q<0>(va[j][4], va[j][5], va[j][6], va[j][7], inva);
          *(unsigned long long*)(hn8 + (size_t)m * DM + 512 * j + 8 * F.lane) = (unsigned long long)lo | ((unsigned long long)hi << 32); }
        { const unsigned lo = pack8x4q<0>(vb[j][0], vb[j][1], vb[j][2], vb[j][3], invb), hi = pack8x4q<0>(vb[j][4], vb[j][5], vb[j][6], vb[j][7], invb);
          *(unsigned long long*)(hn8 + (size_t)(m + 1) * DM + 512 * j + 8 * F.lane) = (unsigned long long)lo | ((unsigned long long)hi << 32); }
        f32x4 wq[8][2];
#pragma unroll
        for (int q = 0; q < 8; ++q) { wq[q][0] = wl[(j * 8 + q) * 64 + F.lane]; wq[q][1] = wl[(16 + j * 8 + q) * 64 + F.lane]; }
#pragma unroll
        for (int q = 0; q < 8; ++q) { const f32x4 wa = wq[q][0], wb = wq[q][1]; const f2_ ta = {va[j][q], va[j][q]}, tb = {vb[j][q], vb[j][q]};
            const f2_ w01 = {wa.x, wa.y}, w23 = {wa.z, wa.w}, w45 = {wb.x, wb.y}, w67 = {wb.z, wb.w};
            la2[0] = __builtin_elementwise_fma(ta, w01, la2[0]); la2[1] = __builtin_elementwise_fma(ta, w23, la2[1]); la2[2] = __builtin_elementwise_fma(ta, w45, la2[2]); la2[3] = __builtin_elementwise_fma(ta, w67, la2[3]);
            lb2[0] = __builtin_elementwise_fma(tb, w01, lb2[0]); lb2[1] = __builtin_elementwise_fma(tb, w23, lb2[1]); lb2[2] = __builtin_elementwise_fma(tb, w45, lb2[2]); lb2[3] = __builtin_elementwise_fma(tb, w67, lb2[3]); } }
    float la[8], lb[8];
#pragma unroll
    for (int e = 0; e < 4; ++e) { la[2 * e] = la2[e].x; la[2 * e + 1] = la2[e].y; lb[2 * e] = lb2[e].x; lb[2 * e + 1] = lb2[e].y; }
#pragma unroll
    for (int e = 0; e < 8; ++e) { (void)e; }
    { const float ya = reduce8_butterfly(la, F.lane), yb = reduce8_butterfly(lb, F.lane);
#pragma unroll
      for (int e = 0; e < 8; ++e) { la[e] = __int_as_float(__builtin_amdgcn_readlane(__float_as_int(ya), 16 * (e >> 1) + 8 * (e & 1))); lb[e] = __int_as_float(__builtin_amdgcn_readlane(__float_as_int(yb), 16 * (e >> 1) + 8 * (e & 1))); } }
    int res = 0;
#pragma unroll
    for (int r = 0; r < 2; ++r) { const float (&lg)[8] = r ? lb : la;
        int e1 = 0; float v1 = lg[0];
#pragma unroll
        for (int e = 1; e < 8; ++e) if (lg[e] > v1) { v1 = lg[e]; e1 = e; }
        int e2 = -1; float v2 = -INFINITY;
#pragma unroll
        for (int e = 0; e < 8; ++e) if (e != e1 && lg[e] > v2) { v2 = lg[e]; e2 = e; }
        const float w1 = __builtin_amdgcn_rcpf(1.0f + __expf(v2 - v1)), w2 = 1.0f - w1;
        if (F.lane == i + r) { kre = e1 | (e2 << 8); kw1 = w1; kw2 = w2; }
        res |= (e1 | (e2 << 8)) << (16 * r); }
    return res;
}
__device__ __forceinline__ void router_part1(Frame& F, const bf16* h, unsigned char* hn8, float* sa, const float* gain, const float* wr  , int* re, float* rw1, float* rw2, int* cnt_g) {
    LAS int* wc = (LAS int*)(F.lds + RING_OFF);
    LAS f32x4* wl = (LAS f32x4*)(F.lds + RING_OFF + 1024);
    for (int c = F.tid; c < 2048; c += NWAVES * 64) { const int k = c >> 1, hf = c & 1; wl[(hf * 16 + (k >> 9) * 8 + (k & 7)) * 64 + ((k >> 3) & 63)] = ((const f32x4*)wr)[c]; }
    float gn[2][8];
#pragma unroll
    for (int j = 0; j < 2; ++j) ld8_f32(gn[j], gain + 512 * j + 8 * F.lane);
    __syncthreads();
    for (int tb = F.bx; tb < MTOK / 128; tb += F.G) {
        int c0 = 0, c1 = 0, c2 = 0, c3 = 0, c4 = 0, c5 = 0, c6 = 0, c7 = 0;
        const int mbase = tb * 128 + F.wave * 16;
        float ksa = 0.f, kw1 = 0.f, kw2 = 0.f; int kre = 0;
        v4u ra[2], rb[2];
#pragma unroll
        for (int j = 0; j < 2; ++j) { ra[j] = *(const v4u*)(h + (size_t)mbase * DM + 512 * j + 8 * F.lane); rb[j] = *(const v4u*)(h + (size_t)(mbase + 1) * DM + 512 * j + 8 * F.lane); }
        for (int i = 0; i < 16; i += 2) {
            const int m = mbase + i, mn = mbase + ((i + 2 < 16) ? i + 2 : i);
            v4u na[2], nb[2];
#pragma unroll
            for (int j = 0; j < 2; ++j) { na[j] = *(const v4u*)(h + (size_t)mn * DM + 512 * j + 8 * F.lane); nb[j] = *(const v4u*)(h + (size_t)(mn + 1) * DM + 512 * j + 8 * F.lane); }
            __builtin_amdgcn_sched_barrier(0);
            float va[2][8], vb[2][8];
#pragma unroll
            for (int j = 0; j < 2; ++j) { unpack8(va[j], ra[j]); unpack8(vb[j], rb[j]); }
            const int ee2 = router_pair(F, m, i, va, vb, gn, hn8, wl, ksa, kre, kw1, kw2);
#pragma unroll
            for (int t = 0; t < 2; ++t) { const int ee = (ee2 >> (16 * t)) & 0xffff, e1 = ee & 0xff, e2 = ee >> 8;
                c0 += (e1 == 0) + (e2 == 0); c1 += (e1 == 1) + (e2 == 1); c2 += (e1 == 2) + (e2 == 2); c3 += (e1 == 3) + (e2 == 3);
                c4 += (e1 == 4) + (e2 == 4); c5 += (e1 == 5) + (e2 == 5); c6 += (e1 == 6) + (e2 == 6); c7 += (e1 == 7) + (e2 == 7); }
#pragma unroll
            for (int j = 0; j < 2; ++j) { ra[j] = na[j]; rb[j] = nb[j]; }
        }
        if (F.lane < 16) { sa[mbase + F.lane] = ksa; re[mbase + F.lane] = kre; rw1[mbase + F.lane] = kw1; rw2[mbase + F.lane] = kw2; }
        if (F.lane == 0) { LAS int* w = wc + F.wave * 8; w[0] = c0; w[1] = c1; w[2] = c2; w[3] = c3; w[4] = c4; w[5] = c5; w[6] = c6; w[7] = c7; }
        __syncthreads();
        if (F.tid < 8) { int s = 0;
#pragma unroll
            for (int w = 0; w < 8; ++w) s += wc[w * 8 + F.tid];
            cnt_g[tb * 8 + F.tid] = s; }
        __syncthreads();
    }
}
__device__ __forceinline__ void router_part2(Frame& F, const unsigned char* hn8, const float* sa, unsigned char* hns8, float* sas, const int* re, const float* rw1, const float* rw2, const int* cnt_g, int* pos1, int* pos2, float* gate, unsigned* ptab) {
    LAS int* cg = (LAS int*)(F.lds + RING_OFF);
    LAS int* tot = cg + 2048; LAS int* pre = cg + 2056; LAS int* wcnt = cg + 2064;
    for (int tb = F.bx; tb < MTOK / 128; tb += F.G) {
        for (int k = F.tid; k < 2048; k += NWAVES * 64) cg[k] = cnt_g[k];
        __syncthreads();
        { const int e = F.wave; int t = 0, p = 0;
#pragma unroll
          for (int q = 0; q < 4; ++q) { const int c = F.lane * 4 + q; const int v = cg[c * 8 + e]; t += v; p += (c < tb) ? v : 0; }
          t = wave_sum_i(t); p = wave_sum_i(p);
          if (F.lane == 0) { tot[e] = t; pre[e] = p; } }
        const bool act = F.lane < 16;
        const int m = tb * 128 + F.wave * 16 + (F.lane & 15);
        const int ee = re[m], e1 = ee & 0xff, e2 = (ee >> 8) & 0xff;
        unsigned long long mk[8];
#pragma unroll
        for (int e = 0; e < 8; ++e) { mk[e] = __ballot(act && (e1 == e || e2 == e)); if (F.lane == e) wcnt[F.wave * 8 + e] = __popcll(mk[e]); }
        __syncthreads();
        int seg = 0, p1 = 0, p2 = 0, mypad0 = 0, mypad1 = 0;
        const unsigned long long lt = (1ull << F.lane) - 1ull;
#pragma unroll
        for (int e = 0; e < 8; ++e) {
            const int te = tot[e]; int bse = seg + pre[e];
            for (int w = 0; w < F.wave; ++w) bse += wcnt[w * 8 + e];
            const int rank = __popcll(mk[e] & lt);
            if (e1 == e) p1 = bse + rank;
            if (e2 == e) p2 = bse + rank;
            const int segn = seg + ((te + 255) & ~255);
            if (tb == e) { mypad0 = seg + te; mypad1 = segn; }
            if (tb == 0) { for (int p = seg / 256 + F.tid; p < segn / 256; p += NWAVES * 64) __hip_atomic_store(ptab + 64 + p, (unsigned)e, __ATOMIC_RELAXED, __HIP_MEMORY_SCOPE_AGENT); }
            if (tb == 0 && F.tid == 0 && e < 7) __hip_atomic_store(ptab + 32 + e, (unsigned)(segn / 256), __ATOMIC_RELAXED, __HIP_MEMORY_SCOPE_AGENT);
            seg = segn;
        }
        if (tb == 0 && F.tid == 0) __hip_atomic_store(ptab, (unsigned)(seg / 256), __ATOMIC_RELAXED, __HIP_MEMORY_SCOPE_AGENT);
        if (act) { pos1[m] = p1; pos2[m] = p2; gate[p1] = rw1[m]; gate[p2] = rw2[m]; const float s = sa[m]; sas[p1] = s; sas[p2] = s; }
        { v4u rowv[16];
#pragma unroll
          for (int i = 0; i < 16; ++i) rowv[i] = *(const GAS v4u*)(hn8 + (size_t)(tb * 128 + F.wave * 16 + i) * DM + F.lane * 16);
#pragma unroll
          for (int i = 0; i < 16; ++i) { const int q1 = __builtin_amdgcn_readlane(p1, i), q2 = __builtin_amdgcn_readlane(p2, i);
              *(GAS v4u*)(hns8 + (size_t)q1 * DM + F.lane * 16) = rowv[i]; *(GAS v4u*)(hns8 + (size_t)q2 * DM + F.lane * 16) = rowv[i]; } }
        if (tb < 8) {
            unsigned zz = 0u; asm volatile("" : "+v"(zz)); const v4u z = {zz, zz, zz, zz};
            for (int r = mypad0 + F.wave; r < mypad1; r += NWAVES) { *(GAS v4u*)(hns8 + (size_t)r * DM + F.lane * 16) = z; if (F.lane == 0) { gate[r] = 0.f; sas[r] = 0.f; } }
        }
        __syncthreads();
    }
}
constexpr int N_PHASES = 35;
#ifndef SKEW_DT
#define SKEW_DT 375u
#endif
#ifndef PG8_ALIGN_EPI
#define PG8_ALIGN_EPI true
#endif
#ifndef PROBE_EPI
#define PROBE_EPI 0
#endif
#ifndef PROBE_DOUBLE
#define PROBE_DOUBLE 0
#endif
struct Args { const float* x; const float* mix_norm; const float* ffn_norm; const float* dil_w_in; const float* dil_w_out; const float* sb_w_qkv; const float* sb_w_out;
              const float* ffn_gu; const float* ffn_dn; const float* moe_router; const float* moe_gu; const float* moe_dn; const float* final_norm; float* out; unsigned char* ws; int lo, hi, li, pad; };
typedef const __attribute__((address_space(4))) Args* KArgs;
__device__ __forceinline__ KArgs kargs() { KArgs p = (KArgs)__builtin_amdgcn_kernarg_segment_ptr(); asm volatile("" : "+s"(p)); return p; }
__device__ __forceinline__ void make_frame(Frame& F, LAS unsigned char* lds, unsigned char* ws, int wave_s) {
    const int t = wave_s * 64 + lane_id_v();
    int bx = blockIdx.x, G = gridDim.x; asm volatile("" : "+s"(bx), "+s"(G));
    F.lds = lds; F.MISC = (volatile LAS unsigned*)(lds + MISC_OFF); F.ctl = (gu32*)(ws + WS_CTL);
    F.tid = t; F.lane = t & 63; F.wave = wave_s;
    F.G = G; F.vcu = (G % 8 == 0) ? (bx % 8) * (G / 8) + bx / 8 : bx; F.bx = bx;
}
#define WPTR(off) ((bf16*)(ws + WS_W + (off)))
__global__ void __launch_bounds__(NWAVES * 64, 2) mk_fwd(Args a_) {
    extern __shared__ __attribute__((aligned(16))) unsigned char lds_[];
    LAS unsigned char* const lds = (LAS unsigned char*)lds_;
    for (int u = threadIdx.x; u < (LDS_BYTES - LDSCTL_OFF) / 4; u += NWAVES * 64) ((LAS unsigned*)(lds + LDSCTL_OFF))[u] = 0u;
    const int wave_s = __builtin_amdgcn_readfirstlane(threadIdx.x >> 6);
    const int t0_ = (threadIdx.x == 0);
    __syncthreads();
    int lo, hi;
    XcdBarrier bar;
    { KArgs ka = kargs(); lo = ka->lo; hi = ka->hi; unsigned* bw = (unsigned*)(ka->ws + WS_CTL) + CW_BAR + ka->li * XCD_BAR_WORDS;
      bar.bar = bw; bar.x = 0; bar.st = nullptr; bar.t0 = 0; bar.wave_s = wave_s;
      if (hi - lo > 1) { bar = xcd_barrier_post(bw, (volatile LAS unsigned*)(lds + MISC_OFF) + 8, t0_); bar.wave_s = wave_s; } }
#define IN(k) (lo <= (k) && (k) < hi)
#ifndef PROBE_BAR
#define PROBE_BAR 0
#endif
#define SEAM(k) do { if (IN(k) && IN((k) + 1)) { xcd_barrier(bar); if (PROBE_BAR) xcd_barrier(bar); } } while (0)
#define CTX() KArgs ka = kargs(); unsigned char* const ws = ka->ws; Frame F; make_frame(F, lds, ws, wave_s); LAS unsigned char* const ring = lds + RING_OFF; (void)ring

    for (int rep_ = 0; rep_ < ((PROBE_DOUBLE & 1) ? 2 : 1); ++rep_)
    if (IN(0)) { CTX();
        float* cm = (float*)(ws + WS_CMAX); unsigned char* w8 = ws + WS_W;
        quant_strips(F, ka->moe_gu,    w8 + W8_MGU,  cm + C_MGU, 16, NGU,    1);
        quant_strips(F, ka->dil_w_in,  w8 + W8_IN,   cm + C_IN,   2, NQKV_D, 0);
        quant_strips(F, ka->ffn_gu,    w8 + W8_FGU,  cm + C_FGU,  2, NGU,    1);
        quant_strips(F, ka->sb_w_qkv,  w8 + W8_SQKV, cm + C_SQKV, 2, NQKV_S, 0);
        quant_strips(F, ka->dil_w_out, w8 + W8_OUT,  cm + C_OUT,  2, DM,     0);
        LAS float* scr = (LAS float*)(ring + F.wave * 16384);
        conv_family(F, ka->moe_dn,    WPTR(W_MDN), 16, FF, DM, 0, scr);
        conv_family(F, ka->ffn_dn,    WPTR(W_FDN),  2, FF, DM, 0, scr);
        conv_family(F, ka->sb_w_out,  WPTR(W_SOUT), 2, DM, DM, 0, scr);
        norm_rows<0>(F, ka->x, (bf16*)(ws + WS_H), ws + WS_HN8, (float*)(ws + WS_SAHN), nullptr, ka->mix_norm, nullptr, nullptr, nullptr);
        __syncthreads();
    }
    SEAM(1);

    for (int lp = 0; lp < 2; ++lp) {
        const int pb = 2 + 16 * lp;
        if (IN(pb + 0)) { CTX();
            if (lp != 0) norm_rows<2>(F, nullptr, (bf16*)(ws + WS_H), ws + WS_HN8, (float*)(ws + WS_SAHN), nullptr, ka->mix_norm + (size_t)(2 * lp) * DM, (const bf16*)(ws + WS_S + S_YS), (const int*)(ws + WS_POS1), (const int*)(ws + WS_POS2));
        }
        if (lp != 0) SEAM(pb + 0);
        for (int rep_ = 0; rep_ < ((PROBE_DOUBLE & 64) ? 2 : 1); ++rep_)
        if (IN(pb + 1)) { CTX(); pg8::Gemm g{(const bf16*)(ws + WS_HN8), (const bf16*)(ws + WS_W + W8_IN + (size_t)lp * NQKV_D * DM), MTOK, NQKV_D, DM / 2}; pg8::StaticOrderT<NQKV_D / 256> S; S.init(MTOK,  NQKV_D, F.G, F.bx, F.wave); S.probe_same = rep_;
            pg8::EpiStore<true, 2> E{(bf16*)(ws + WS_BIG), NQKV_D, (const float*)(ws + WS_SAHN), (const float*)(ws + WS_CMAX) + C_IN + lp * NQKV_D, 0.125f * 1.4426950408889634f};
            pg8::gemm_phase<pg8::EpiStore<true, 2>, decltype(S), PG8_ALIGN_EPI, true>(ring, g, S, E); }
        SEAM(pb + 1);
        for (int rep_ = 0; rep_ < ((PROBE_DOUBLE & 2) ? 2 : 1); ++rep_)
        if (IN(pb + 2)) { CTX(); att::dilated_phase2((const bf16*)(ws + WS_BIG), ws + WS_S + S_OG, (float*)(ws + WS_S + S_LSE), (float*)(ws + WS_S + S_OSC), ring, F.vcu, F.G, F.tid, F.wave, F.lane); }
        SEAM(pb + 2);
        for (int rep_ = 0; rep_ < ((PROBE_DOUBLE & 4) ? 2 : 1); ++rep_)
        if (IN(pb + 3)) { CTX(); for (int m = F.vcu * NWAVES + F.wave; m < MTOK; m += F.G * NWAVES * 2) att::dilated_combine_2rows(ws + WS_S + S_OG, (const float*)(ws + WS_S + S_LSE), (const float*)(ws + WS_S + S_OSC), ws + WS_Y, (float*)(ws + WS_SAY), m, m + F.G * NWAVES, F.lane); }
        SEAM(pb + 3);
        if (IN(pb + 4)) { CTX(); pg8::Gemm g{(const bf16*)(ws + WS_Y), (const bf16*)(ws + WS_W + W8_OUT + (size_t)lp * DM * DM), MTOK, DM, DM / 2}; pg8::StaticOrderT<DM / 256> S; S.init(MTOK,  DM, F.G, F.bx, F.wave);
            pg8::EpiResid<true> E{(bf16*)(ws + WS_H), DM, (const float*)(ws + WS_SAY), (const float*)(ws + WS_CMAX) + C_OUT + lp * DM};
            pg8::gemm_phase<pg8::EpiResid<true>, decltype(S), PG8_ALIGN_EPI, true>(ring, g, S, E); }
        SEAM(pb + 4);
        for (int rep_ = 0; rep_ < ((PROBE_DOUBLE & 8) ? 2 : 1); ++rep_)
        if (IN(pb + 5)) { CTX(); norm_rows<1>(F, nullptr, (bf16*)(ws + WS_H), ws + WS_HN8, (float*)(ws + WS_SAHN), nullptr, ka->ffn_norm + (size_t)(2 * lp) * DM, nullptr, nullptr, nullptr); }
        SEAM(pb + 5);
        for (int rep_ = 0; rep_ < ((PROBE_DOUBLE & 128) ? 2 : 1); ++rep_)
        if (IN(pb + 6)) { CTX(); pg8::Gemm g{(const bf16*)(ws + WS_HN8), (const bf16*)(ws + WS_W + W8_FGU + (size_t)lp * NGU * DM), MTOK, NGU, DM / 2}; pg8::StaticOrderT<NGU / 256> S; S.init(MTOK,  NGU, F.G, F.bx, F.wave);
            pg8::EpiSwiGLU<true> E{(bf16*)(ws + WS_BIG), FF, (const float*)(ws + WS_SAHN), (const float*)(ws + WS_CMAX) + C_FGU + lp * NGU};
            pg8::gemm_phase<pg8::EpiSwiGLU<true>, decltype(S), PG8_ALIGN_EPI, true>(ring, g, S, E); }
        SEAM(pb + 6);
        if (IN(pb + 7)) { CTX(); pg8::Gemm g{(const bf16*)(ws + WS_BIG), WPTR(W_FDN) + (size_t)lp * DM * FF, MTOK, DM, FF}; pg8::StaticOrderT<DM / 256> S; S.init(MTOK,  DM, F.G, F.bx, F.wave); pg8::EpiResid<false> E{(bf16*)(ws + WS_H), DM, nullptr, nullptr};
            pg8::gemm_phase<pg8::EpiResid<false>, decltype(S), PG8_ALIGN_EPI, true>(ring, g, S, E); }
        SEAM(pb + 7);
        for (int rep_ = 0; rep_ < ((PROBE_DOUBLE & 8) ? 2 : 1); ++rep_)
        if (IN(pb + 8)) { CTX(); norm_rows<1>(F, nullptr, (bf16*)(ws + WS_H), ws + WS_HN8, (float*)(ws + WS_SAHN), nullptr, ka->mix_norm + (size_t)(2 * lp + 1) * DM, nullptr, nullptr, nullptr); }
        SEAM(pb + 8);
        for (int rep_ = 0; rep_ < ((PROBE_DOUBLE & 1024) ? 2 : 1); ++rep_)
        if (IN(pb + 9)) { CTX(); pg8::Gemm g{(const bf16*)(ws + WS_HN8), (const bf16*)(ws + WS_W + W8_SQKV + (size_t)lp * NQKV_S * DM), MTOK, NQKV_S, DM / 2}; pg8::StaticOrderT<NQKV_S / 256> S; S.init(MTOK,  NQKV_S, F.G, F.bx, F.wave);
            pg8::EpiStore<true, 1> E{(bf16*)(ws + WS_BIG), NQKV_S, (const float*)(ws + WS_SAHN), (const float*)(ws + WS_CMAX) + C_SQKV + lp * NQKV_S, 0.125f * 1.4426950408889634f};
            pg8::gemm_phase<pg8::EpiStore<true, 1>, decltype(S), PG8_ALIGN_EPI, true>(ring, g, S, E); }
        SEAM(pb + 9);
        for (int rep_ = 0; rep_ < ((PROBE_DOUBLE & 16) ? 2 : 1); ++rep_)
        if (IN(pb + 10)) { CTX(); att::sb_phase((const bf16*)(ws + WS_BIG), (bf16*)(ws + WS_Y), ring, F.vcu, F.G, F.tid, F.wave, F.lane); }
        SEAM(pb + 10);
        if (IN(pb + 11)) { CTX(); pg8::Gemm g{(const bf16*)(ws + WS_Y), WPTR(W_SOUT) + (size_t)lp * DM * DM, MTOK, DM, DM}; pg8::StaticOrderT<DM / 256> S; S.init(MTOK,  DM, F.G, F.bx, F.wave); pg8::EpiResid<false> E{(bf16*)(ws + WS_H), DM, nullptr, nullptr};
            pg8::gemm_phase<pg8::EpiResid<false>, decltype(S), PG8_ALIGN_EPI, true>(ring, g, S, E); }
        SEAM(pb + 11);
        for (int rep_ = 0; rep_ < ((PROBE_DOUBLE & 32) ? 2 : 1); ++rep_)
        if (IN(pb + 12)) { CTX(); router_part1(F, (const bf16*)(ws + WS_H), ws + WS_HN8, (float*)(ws + WS_SAHN), ka->ffn_norm + (size_t)(2 * lp + 1) * DM, ka->moe_router + (size_t)lp * DM * NEXP,
                                               (int*)(ws + WS_RE), (float*)(ws + WS_RW1), (float*)(ws + WS_RW2), (int*)(ws + WS_CNT)); }
        SEAM(pb + 12);
        for (int rep_ = 0; rep_ < ((PROBE_DOUBLE & 32) ? 2 : 1); ++rep_)
        if (IN(pb + 13)) { CTX(); router_part2(F, ws + WS_HN8, (const float*)(ws + WS_SAHN), ws + WS_S + S_HNS, (float*)(ws + WS_SAHNS), (const int*)(ws + WS_RE), (const float*)(ws + WS_RW1), (const float*)(ws + WS_RW2), (const int*)(ws + WS_CNT),
                                               (int*)(ws + WS_POS1), (int*)(ws + WS_POS2), (float*)(ws + WS_GATE), (unsigned*)(ws + WS_PTAB)); }
        SEAM(pb + 13);
        for (int rep_ = 0; rep_ < ((PROBE_DOUBLE & 256) ? 2 : 1); ++rep_)
        if (IN(pb + 14)) { CTX(); unsigned* ptab = (unsigned*)(ws + WS_PTAB); const int npan = (int)__builtin_amdgcn_readfirstlane(__hip_atomic_load(ptab, __ATOMIC_RELAXED, __HIP_MEMORY_SCOPE_AGENT));
            pg8::Gemm g{(const bf16*)(ws + WS_S + S_HNS), (const bf16*)(ws + WS_W + W8_MGU + (size_t)lp * NEXP * NGU * DM), npan * 256, NGU, DM / 2}; pg8::StaticOrderT<NGU / 256> S; S.init(npan * 256,  NGU, F.G, F.bx, F.wave, ptab + 64);
            pg8::EpiSwiGLU<true> E{(bf16*)(ws + WS_BIG), FF, (const float*)(ws + WS_SAHNS), (const float*)(ws + WS_CMAX) + C_MGU + lp * NEXP * NGU};
            pg8::gemm_phase<pg8::EpiSwiGLU<true>, decltype(S), PG8_ALIGN_EPI, true>(ring, g, S, E); }
        SEAM(pb + 14);
        for (int rep_ = 0; rep_ < ((PROBE_DOUBLE & 512) ? 2 : 1); ++rep_)
        if (IN(pb + 15)) { CTX(); unsigned* ptab = (unsigned*)(ws + WS_PTAB); const int npan = (int)__builtin_amdgcn_readfirstlane(__hip_atomic_load(ptab, __ATOMIC_RELAXED, __HIP_MEMORY_SCOPE_AGENT));
            pg8::Gemm g{(const bf16*)(ws + WS_BIG), WPTR(W_MDN) + (size_t)lp * NEXP * DM * FF, npan * 256, DM, FF}; pg8::StaticOrderT<DM / 256> S; S.init(npan * 256,  DM, F.G, F.bx, F.wave, ptab + 64); pg8::EpiMoeDown E{(bf16*)(ws + WS_S + S_YS), DM, (const float*)(ws + WS_GATE)};
            pg8::gemm_phase<pg8::EpiMoeDown, decltype(S), PG8_ALIGN_EPI, true>(ring, g, S, E); }
        SEAM(pb + 15);
    }
    if (IN(34)) { CTX(); norm_rows<3>(F, nullptr, (bf16*)(ws + WS_H), nullptr, nullptr, ka->out, ka->final_norm, (const bf16*)(ws + WS_S + S_YS), (const int*)(ws + WS_POS1), (const int*)(ws + WS_POS2)); }
#undef IN
#undef SEAM
#undef CTX
}

#ifndef MK_SINGLE
#define MK_SINGLE 1
#endif
extern "C" void kernel_launch(void* const* d_in, const int* in_sizes, int n_in, void* d_out, int out_size, void* d_ws, size_t ws_size, hipStream_t stream) {
    static int grid = 0;
    if (grid == 0) {
        if (n_in != 13 || in_sizes[0] != MTOK * DM || out_size != MTOK * DM || ws_size < WS_END) { fprintf(stderr, "kernel_launch: unexpected shapes / workspace (n_in %d, ws %zu)\n", n_in, ws_size); grid = -1; return; }
        int dev = 0, cus = 0, per_cu = 0;
        if (hipGetDevice(&dev) != hipSuccess || hipDeviceGetAttribute(&cus, hipDeviceAttributeMultiprocessorCount, dev) != hipSuccess) { grid = -1; return; }
        if (hipFuncSetAttribute((const void*)mk_fwd, hipFuncAttributeMaxDynamicSharedMemorySize, LDS_BYTES) != hipSuccess) { grid = -1; return; }
        if (hipOccupancyMaxActiveBlocksPerMultiprocessor(&per_cu, (const void*)mk_fwd, NWAVES * 64, LDS_BYTES) != hipSuccess || per_cu < 1) { fprintf(stderr, "kernel_launch: the occupancy query admits %d workgroups of this kernel per CU: the grid barrier needs one resident workgroup per CU; nothing launched\n", per_cu); (void)hipGetLastError(); grid = -1; return; }
        (void)hipGetLastError();
        grid = cus;
    }
    if (grid < 0) return;
    if (hipMemsetAsync((char*)d_ws + WS_CTL, 0, CTL_ZERO_BYTES, stream) != hipSuccess) return;
    Args a{};
    a.x = (const float*)d_in[0]; a.mix_norm = (const float*)d_in[1]; a.ffn_norm = (const float*)d_in[2]; a.dil_w_in = (const float*)d_in[3]; a.dil_w_out = (const float*)d_in[4];
    a.sb_w_qkv = (const float*)d_in[5]; a.sb_w_out = (const float*)d_in[6]; a.ffn_gu = (const float*)d_in[7]; a.ffn_dn = (const float*)d_in[8]; a.moe_router = (const float*)d_in[9];
    a.moe_gu = (const float*)d_in[10]; a.moe_dn = (const float*)d_in[11]; a.final_norm = (const float*)d_in[12]; a.out = (float*)d_out; a.ws = (unsigned char*)d_ws; a.pad = 0;
#if MK_SINGLE
    a.lo = 0; a.hi = N_PHASES; a.li = 0;
    hipLaunchKernelGGL(mk_fwd, dim3(grid), dim3(NWAVES * 64), LDS_BYTES, stream, a);
#else
    for (int ph = 0; ph < N_PHASES; ++ph) { a.lo = ph; a.hi = ph + 1; a.li = 0; hipLaunchKernelGGL(mk_fwd, dim3(grid), dim3(NWAVES * 64), LDS_BYTES, stream, a); }
#endif
}
```

```cpp
#include <hip/hip_runtime.h>
#include <cstdio>
#include <cstdint>
__device__ __forceinline__ int lane_id_v() { int l; asm volatile("v_mbcnt_lo_u32_b32 %0, -1, 0\n\tv_mbcnt_hi_u32_b32 %0, -1, %0" : "=v"(l)); return l; }
template <int O> __device__ __forceinline__ unsigned xshfl_u(unsigned v) {
    if constexpr (O >= 32) { auto r = __builtin_amdgcn_permlane32_swap(v, v, false, false); return (lane_id_v() < 32) ? r[1] : r[0]; }
    else return (unsigned)__builtin_amdgcn_ds_swizzle((int)v, (O << 10) | 0x1F);
}
template <int O> __device__ __forceinline__ float xshfl(float v) { return __uint_as_float(xshfl_u<O>(__float_as_uint(v))); }
template <int O> __device__ __forceinline__ int xshfl(int v) { return (int)xshfl_u<O>((unsigned)v); }
template <int CTRL> __device__ __forceinline__ float dppf(float v) { return __int_as_float(__builtin_amdgcn_update_dpp(0, __float_as_int(v), CTRL, 0xF, 0xF, true)); }
template <int CTRL> __device__ __forceinline__ int dppi(int v) { return __builtin_amdgcn_update_dpp(0, v, CTRL, 0xF, 0xF, true); }
__device__ __forceinline__ float wave_sum(float v) {
    v += dppf<0xB1>(v); v += dppf<0x4E>(v); v += dppf<0x141>(v); v += dppf<0x140>(v);
    { auto r = __builtin_amdgcn_permlane16_swap(__float_as_uint(v), __float_as_uint(v), false, false); v = __uint_as_float(r[0]) + __uint_as_float(r[1]); }
    { auto r = __builtin_amdgcn_permlane32_swap(__float_as_uint(v), __float_as_uint(v), false, false); v = __uint_as_float(r[0]) + __uint_as_float(r[1]); }
    return v;
}
__device__ __forceinline__ float wave_max(float v) {
    v = fmaxf(v, dppf<0xB1>(v)); v = fmaxf(v, dppf<0x4E>(v)); v = fmaxf(v, dppf<0x141>(v)); v = fmaxf(v, dppf<0x140>(v));
    { auto r = __builtin_amdgcn_permlane16_swap(__float_as_uint(v), __float_as_uint(v), false, false); v = fmaxf(__uint_as_float(r[0]), __uint_as_float(r[1])); }
    { auto r = __builtin_amdgcn_permlane32_swap(__float_as_uint(v), __float_as_uint(v), false, false); v = fmaxf(__uint_as_float(r[0]), __uint_as_float(r[1])); }
    return v;
}
__device__ __forceinline__ int wave_sum_i(int v) {
    v += dppi<0xB1>(v); v += dppi<0x4E>(v); v += dppi<0x141>(v); v += dppi<0x140>(v);
    { auto r = __builtin_amdgcn_permlane16_swap((unsigned)v, (unsigned)v, false, false); v = (int)(r[0] + r[1]); }
    { auto r = __builtin_amdgcn_permlane32_swap((unsigned)v, (unsigned)v, false, false); v = (int)(r[0] + r[1]); }
    return v;
}
namespace pg8 {
#define PG8_LAS __attribute__((address_space(3)))
typedef unsigned short bf16_t;
typedef short bf16x8 __attribute__((ext_vector_type(8)));
typedef float f32x4 __attribute__((ext_vector_type(4)));
typedef unsigned u32x4 __attribute__((ext_vector_type(4)));
typedef int i32x4 __attribute__((ext_vector_type(4)));
template <bool I8> struct Mma;
template <> struct Mma<false> { typedef f32x4 acc_t; static __device__ __forceinline__ acc_t run(bf16x8 b, bf16x8 a, acc_t c) { return __builtin_amdgcn_mfma_f32_16x16x32_bf16(b, a, c, 0, 0, 0); } };
template <> struct Mma<true>  { typedef i32x4 acc_t; static __device__ __forceinline__ acc_t run(bf16x8 b, bf16x8 a, acc_t c) { return __builtin_amdgcn_mfma_i32_16x16x64_i8(__builtin_bit_cast(i32x4, b), __builtin_bit_cast(i32x4, a), c, 0, 0, 0); } };
constexpr int BM = 256, BK = 64, HALF = 128, HTB = HALF * BK * 2  , STAGE_BYTES = 8 * HTB, NXCD = 8, WGM = 4;

__host__ __device__ __forceinline__ int lds_byte(int r, int c) { const int st = (r >> 4) * 2 + (c >> 5), rr = r & 15, cc = c & 31, ob = rr * 64 + cc * 2; return st * 1024 + (ob ^ (((ob >> 9) & 1) << 5)); }
__host__ __device__ __forceinline__ void stage_rc(int b, int& R, int& C) { const int st = b / 1024, sb = b % 1024, swz = sb ^ (((sb >> 9) & 1) << 5); R = (st >> 1) * 16 + swz / 64; C = (st & 1) * 32 + (swz % 64) / 2; }
__host__ __device__ __forceinline__ int perm32(int rho) { const int n = rho >> 4, i = rho & 15; return 8 * (i >> 2) + 4 * n + (i & 3); }

struct Unit { int pm, pn, pb, koff, aux; };
struct Gemm { const bf16_t* A; const bf16_t* Bt; int M, N, K, ld = 0; };

template <int NN  > struct StaticOrderT {
    int nM, nN, nwg, G, c, wave_s, probe_same = 0; const unsigned* pexp; int segp[7];
    __device__ __forceinline__ void init(int M, int N, int G_, int c_, int wave_s_, const unsigned* pexp_ = nullptr) { nM = M / BM; nN = NN; nwg = nM * NN; G = G_; c = c_; wave_s = wave_s_; pexp = pexp_;
        if (pexp) {
#pragma unroll
            for (int e = 0; e < 7; ++e) segp[e] = (int)__builtin_amdgcn_readfirstlane(__hip_atomic_load(pexp - 32 + e, __ATOMIC_RELAXED, __HIP_MEMORY_SCOPE_AGENT)); } }
    int limit = 0x7fffffff;
    __device__ __forceinline__ void map(int L, Unit& u) const {
        int wgid = L; { const int q = nwg / NXCD, r = nwg % NXCD, xcd = wgid % NXCD, off = wgid / NXCD; wgid = (xcd < r ? xcd * (q + 1) : r * (q + 1) + (xcd - r) * q) + off; }
        constexpr int nig = WGM * NN; const int gid = wgid / nig, rem = wgid - gid * nig, fm = gid * WGM, gsz = (nM - fm) < WGM ? (nM - fm) : WGM;
        if (gsz == WGM) { u.pm = fm + rem % WGM; u.pn = rem / WGM; } else { u.pm = fm + rem % gsz; u.pn = rem / gsz; }
        u.koff = 0; u.aux = 0;
        if (probe_same) { u.pm = 0; u.pn = 0; }
        if (pexp) { int ex = 0;
#pragma unroll
            for (int e = 0; e < 7; ++e) ex += (u.pm >= segp[e]) ? 1 : 0;
            u.pb = ex * NN + u.pn; } else u.pb = u.pn;
    }
    __device__ __forceinline__ bool next(int i, Unit& u) const {
        const long L = (long)i * G + c; if (L >= nwg || L >= limit) return false;
        map((int)L, u); return true;
    }
    __device__ __forceinline__ void a_ready(const Unit&) const {}
    __device__ __forceinline__ void done(const Unit&) const {}
};


__device__ __forceinline__ unsigned cvt_pk_bf16(float lo, float hi) { unsigned r; asm volatile("v_cvt_pk_bf16_f32 %0, %1, %2" : "=v"(r) : "v"(lo), "v"(hi)); return r; }
template <class Epi, class Sched, bool ALIGN_EPI = false, bool SP2 = false>
__device__ __forceinline__ void gemm_phase(PG8_LAS unsigned char* lds, const Gemm g, const Sched& S, const Epi& E, unsigned skew_ticks = 0) {
    if (skew_ticks) { const unsigned long long t0_ = __builtin_amdgcn_s_memrealtime(); while (__builtin_amdgcn_s_memrealtime() - t0_ < (unsigned long long)skew_ticks) __builtin_amdgcn_s_sleep(8); }
    const int tid_ = S.wave_s * 64 + lane_id_v();
    const int tid = tid_, wid = __builtin_amdgcn_readfirstlane(tid >> 6), lane = tid & 63, wr = wid >> 2, wc = wid & 3, fr = lane & 15, fq = lane >> 4;
    const int K = g.K, nt = K / BK, ld = g.ld ? g.ld : g.K;
    unsigned voffA[2], voffB[2];
#pragma unroll
    for (int i = 0; i < 2; ++i) { int R, C; stage_rc(tid * 16 + i * 8192, R, C); const int Rb = Epi::PERM ? ((R & ~31) + perm32(R & 31)) : R;
        voffA[i] = (unsigned)(R * ld + C) * 2u; voffB[i] = (unsigned)(Rb * ld + C) * 2u; }
    const size_t kstep = (size_t)(BK * 2);
    const size_t hstep = (size_t)HALF * ld * 2;
    const size_t tstep = 2 * hstep;
    const unsigned ldsw = (unsigned)wid * 1024u;
    const int aoff = lds_byte(wr * 64 + fr, fq * 8), boff = lds_byte(wc * 32 + fr, fq * 8);
#define PG8_SA(b, h) (((b) * 2 + (h)) * HTB)
#define PG8_SB(b, h) ((4 + (b) * 2 + (h)) * HTB)
#define PG8_STAGE(bufoff, gbase, voff) do { _Pragma("unroll") for (int _i = 0; _i < 2; ++_i) \
        __builtin_amdgcn_global_load_lds((const unsigned*)((const char*)(gbase) + (voff)[_i]), (PG8_LAS unsigned*)(lds + (bufoff) + ldsw + _i * 8192), 16, 0, 0); } while (0)
#define PG8_LDA(dst, b, h) do { _Pragma("unroll") for (int m = 0; m < 4; ++m) _Pragma("unroll") for (int k = 0; k < 2; ++k) dst[m][k] = *(const PG8_LAS bf16x8*)(lds + PG8_SA(b, h) + aoff + m * 2048 + k * 1024); } while (0)
#define PG8_LDB(dst, b, h) do { _Pragma("unroll") for (int n = 0; n < 2; ++n) _Pragma("unroll") for (int k = 0; k < 2; ++k) dst[n][k] = *(const PG8_LAS bf16x8*)(lds + PG8_SB(b, h) + boff + n * 2048 + k * 1024); } while (0)
#define PG8_MMA(ai, bj, At, Bt) do { __builtin_amdgcn_s_setprio(1); _Pragma("unroll") for (int m = 0; m < 4; ++m) _Pragma("unroll") for (int n = 0; n < 2; ++n) _Pragma("unroll") for (int k = 0; k < 2; ++k) \
        acc[ai][bj][m][n] = Mma<Epi::I8>::run(Bt[n][k], At[m][k], acc[ai][bj][m][n]); __builtin_amdgcn_s_setprio(0); } while (0)
#define PG8_MMA0(ai, bj, At, Bt) do { __builtin_amdgcn_s_setprio(1); _Pragma("unroll") for (int m = 0; m < 4; ++m) _Pragma("unroll") for (int n = 0; n < 2; ++n) { \
        acc[ai][bj][m][n] = Mma<Epi::I8>::run(Bt[n][0], At[m][0], acc_zero); acc[ai][bj][m][n] = Mma<Epi::I8>::run(Bt[n][1], At[m][1], acc[ai][bj][m][n]); } __builtin_amdgcn_s_setprio(0); } while (0)
#define PG8_WAIT_V(n) asm volatile("s_waitcnt vmcnt(" #n ")" ::: "memory")
#define PG8_WAIT_L(n) asm volatile("s_waitcnt lgkmcnt(" #n ")" ::: "memory")
#define PG8_BAR __builtin_amdgcn_s_barrier()
#define PG8_SCHED __builtin_amdgcn_sched_barrier(0)
    Unit cur, nxt; int ui = 0;
    if (!S.next(0, cur)) return;
    typedef typename Mma<Epi::I8>::acc_t acc_t; const acc_t acc_zero = {};
    acc_t acc[2][2][4][2];
    if constexpr (!SP2) {
#pragma unroll
    for (int a = 0; a < 2; ++a)
#pragma unroll
        for (int b = 0; b < 2; ++b)
#pragma unroll
            for (int m = 0; m < 4; ++m)
#pragma unroll
                for (int n = 0; n < 2; ++n) acc[a][b][m][n] = acc_zero;
    }
    bf16x8 At[4][2], B0[2][2], B1[2][2];
    const char* cA = (const char*)g.A + (size_t)cur.pm * tstep + cur.koff; const char* cB = (const char*)g.Bt + (size_t)cur.pb * tstep + cur.koff;
    S.a_ready(cur);
    if constexpr (SP2) {
        PG8_STAGE(PG8_SB(0, 0), cB, voffB); PG8_STAGE(PG8_SB(0, 1), cB + hstep, voffB); PG8_STAGE(PG8_SA(0, 0), cA, voffA); PG8_STAGE(PG8_SA(0, 1), cA + hstep, voffA);
        if (wr == 1) PG8_BAR;
        PG8_WAIT_V(2); PG8_BAR;
        PG8_STAGE(PG8_SB(1, 0), cB + kstep, voffB); PG8_STAGE(PG8_SA(1, 0), cA + kstep, voffA); PG8_STAGE(PG8_SB(1, 1), cB + hstep + kstep, voffB); PG8_STAGE(PG8_SA(1, 1), cA + hstep + kstep, voffA);
        PG8_WAIT_V(0); PG8_BAR;
    } else {
        PG8_STAGE(PG8_SB(0, 0), cB, voffB); PG8_STAGE(PG8_SA(0, 0), cA, voffA); PG8_STAGE(PG8_SB(0, 1), cB + hstep, voffB); PG8_STAGE(PG8_SA(0, 1), cA + hstep, voffA);
        if (wr == 1) PG8_BAR;
        PG8_WAIT_V(4); PG8_BAR;
        PG8_STAGE(PG8_SB(1, 0), cB + kstep, voffB); PG8_STAGE(PG8_SA(1, 0), cA + kstep, voffA); PG8_STAGE(PG8_SB(1, 1), cB + hstep + kstep, voffB);
        PG8_WAIT_V(6); PG8_BAR;
    }
    for (;;) {
        const bool has_next = S.next(ui + 1, nxt);
        const char* nA = has_next ? (const char*)g.A + (size_t)nxt.pm * tstep + nxt.koff : cA; const char* nB = has_next ? (const char*)g.Bt + (size_t)nxt.pb * tstep + nxt.koff : cB;
        if constexpr (SP2) {
        { const int t = 0;
            if constexpr (Epi::NSC != 0) E.stage(cur, lds + STAGE_BYTES + 4096 + (ui & 1) * 2048, wid, lane_id_v());
            const bool last = false;
            const char* a1 = cA + (size_t)(t + 1) * kstep;
            const char* a2 = last ? nA : cA + (size_t)(t + 2) * kstep; const char* b2 = last ? nB : cB + (size_t)(t + 2) * kstep;
            const char* a3 = a2 + kstep; const char* b3 = b2 + kstep;
            if (last && has_next) S.a_ready(nxt);
#define PG8_WV1 asm volatile("s_waitcnt vmcnt(%0)" :: "n"(Epi::NST + Epi::NSC + (Epi::DRAINS ? 0 : 8)) : "memory")
#define PG8_WV2 asm volatile("s_waitcnt vmcnt(%0)" :: "n"(Epi::NST + Epi::NSC + (Epi::DRAINS ? 6 : 8)) : "memory")
#define PG8_WV3 asm volatile("s_waitcnt vmcnt(%0)" :: "n"(Epi::NST + Epi::NSC + 8) : "memory")
            PG8_LDB(B0, 0, 0); PG8_LDB(B1, 0, 1); PG8_SCHED; PG8_LDA(At, 0, 0);
            PG8_WV1;
            PG8_WAIT_L(0); PG8_BAR; PG8_MMA0(0, 0, At, B0); PG8_MMA0(0, 1, At, B1); PG8_BAR; PG8_SCHED; (void)a1;
            PG8_LDA(At, 0, 1); PG8_STAGE(PG8_SB(0, 0), b2, voffB); PG8_STAGE(PG8_SB(0, 1), b2 + hstep, voffB); PG8_STAGE(PG8_SA(0, 0), a2, voffA);
            PG8_WV2;
            PG8_WAIT_L(0); PG8_BAR; PG8_MMA0(1, 0, At, B0); PG8_MMA0(1, 1, At, B1); PG8_BAR; PG8_SCHED;
            PG8_LDB(B0, 1, 0); PG8_LDB(B1, 1, 1); PG8_SCHED; PG8_LDA(At, 1, 0); PG8_STAGE(PG8_SA(0, 1), a2 + hstep, voffA);
            PG8_WV3; PG8_WAIT_L(0); PG8_BAR; PG8_MMA(0, 0, At, B0); PG8_MMA(0, 1, At, B1); PG8_BAR; PG8_SCHED;
            PG8_LDA(At, 1, 1); PG8_STAGE(PG8_SB(1, 0), b3, voffB); PG8_STAGE(PG8_SB(1, 1), b3 + hstep, voffB); PG8_STAGE(PG8_SA(1, 0), a3, voffA);
            PG8_WAIT_V(8); PG8_WAIT_L(0); PG8_BAR; PG8_MMA(1, 0, At, B0); PG8_MMA(1, 1, At, B1); PG8_SCHED;
#undef PG8_WV1
#undef PG8_WV2
#undef PG8_WV3
                }
        for (int t = 2; t < nt; t += 2) {
            PG8_BAR;
            const bool last = (t == nt - 2);
            const char* a1 = cA + (size_t)(t + 1) * kstep;
            const char* a2 = last ? nA : cA + (size_t)(t + 2) * kstep; const char* b2 = last ? nB : cB + (size_t)(t + 2) * kstep;
            const char* a3 = a2 + kstep; const char* b3 = b2 + kstep;
            if (last && has_next) S.a_ready(nxt);
#define PG8_WV1 PG8_WAIT_V(8)
#define PG8_WV2 PG8_WAIT_V(8)
            PG8_LDB(B0, 0, 0); PG8_LDB(B1, 0, 1); PG8_SCHED; PG8_LDA(At, 0, 0); PG8_STAGE(PG8_SA(1, 1), a1 + hstep, voffA);
            PG8_WV1;
            PG8_WAIT_L(0); PG8_BAR; PG8_MMA(0, 0, At, B0); PG8_MMA(0, 1, At, B1); PG8_BAR; PG8_SCHED;
            PG8_LDA(At, 0, 1); PG8_STAGE(PG8_SB(0, 0), b2, voffB); PG8_STAGE(PG8_SB(0, 1), b2 + hstep, voffB); PG8_STAGE(PG8_SA(0, 0), a2, voffA);
            PG8_WV2;
            PG8_WAIT_L(0); PG8_BAR; PG8_MMA(1, 0, At, B0); PG8_MMA(1, 1, At, B1); PG8_BAR; PG8_SCHED;
            PG8_LDB(B0, 1, 0); PG8_LDB(B1, 1, 1); PG8_SCHED; PG8_LDA(At, 1, 0); PG8_STAGE(PG8_SA(0, 1), a2 + hstep, voffA);
            PG8_WAIT_V(8); PG8_WAIT_L(0); PG8_BAR; PG8_MMA(0, 0, At, B0); PG8_MMA(0, 1, At, B1); PG8_BAR; PG8_SCHED;
            PG8_LDA(At, 1, 1); PG8_STAGE(PG8_SB(1, 0), b3, voffB); PG8_STAGE(PG8_SB(1, 1), b3 + hstep, voffB); PG8_STAGE(PG8_SA(1, 0), a3, voffA);
            PG8_WAIT_V(8); PG8_WAIT_L(0); PG8_BAR; PG8_MMA(1, 0, At, B0); PG8_MMA(1, 1, At, B1); PG8_SCHED;
#undef PG8_WV1
#undef PG8_WV2
                }
        } else {
        for (int t = 0; t < nt; t += 2) {
            const bool last = (t == nt - 2);
            const char* a1 = cA + (size_t)(t + 1) * kstep;
            const char* a2 = last ? nA : cA + (size_t)(t + 2) * kstep; const char* b2 = last ? nB : cB + (size_t)(t + 2) * kstep;
            const char* a3 = a2 + kstep; const char* b3 = b2 + kstep;
            if (last && has_next) S.a_ready(nxt);
            PG8_LDB(B0, 0, 0); PG8_SCHED; PG8_LDA(At, 0, 0); PG8_STAGE(PG8_SA(1, 1), a1 + hstep, voffA);
            PG8_WAIT_L(8); PG8_BAR; PG8_WAIT_L(0); PG8_MMA(0, 0, At, B0); PG8_BAR; PG8_SCHED;
            PG8_LDB(B1, 0, 1); PG8_STAGE(PG8_SB(0, 0), b2, voffB);
            PG8_BAR; PG8_WAIT_L(0); PG8_MMA(0, 1, At, B1); PG8_BAR;
            PG8_LDA(At, 0, 1); PG8_STAGE(PG8_SA(0, 0), a2, voffA);
            PG8_BAR; PG8_WAIT_L(0); PG8_MMA(1, 0, At, B0); PG8_BAR; PG8_SCHED;
            PG8_STAGE(PG8_SB(0, 1), b2 + hstep, voffB);
            PG8_WAIT_V(6); PG8_BAR; PG8_MMA(1, 1, At, B1); PG8_BAR;
            PG8_LDB(B0, 1, 0); PG8_SCHED; PG8_LDA(At, 1, 0); PG8_STAGE(PG8_SA(0, 1), a2 + hstep, voffA);
            PG8_WAIT_L(8); PG8_BAR; PG8_WAIT_L(0); PG8_MMA(0, 0, At, B0); PG8_BAR; PG8_SCHED;
            PG8_LDB(B1, 1, 1); PG8_STAGE(PG8_SB(1, 0), b3, voffB);
            PG8_BAR; PG8_WAIT_L(0); PG8_MMA(0, 1, At, B1); PG8_BAR;
            PG8_LDA(At, 1, 1); PG8_STAGE(PG8_SA(1, 0), a3, voffA);
            PG8_BAR; PG8_WAIT_L(0); PG8_MMA(1, 0, At, B0); PG8_BAR; PG8_SCHED;
            PG8_STAGE(PG8_SB(1, 1), b3 + hstep, voffB);
            PG8_WAIT_V(6); PG8_BAR; PG8_MMA(1, 1, At, B1); PG8_BAR;
        }
        }
        static_assert(!SP2 || ALIGN_EPI, "SP2 leaves the unit's last trailing barrier to the two statements around the epilogue");
        if constexpr (ALIGN_EPI) { if (wr == 0) PG8_BAR; }
        PG8_STAGE(PG8_SA(1, 1), nA + kstep + hstep, voffA);
        if constexpr (!Epi::AFTER_DRAIN) { const int l_ = lane_id_v(); E(acc, cur, wr, wc, l_ & 15, l_ >> 4, (const PG8_LAS float*)(lds + STAGE_BYTES + 4096 + (ui & 1) * 2048)); S.done(cur); }
        if (!has_next) break;
        if constexpr (!SP2) {
#pragma unroll
        for (int a = 0; a < 2; ++a)
#pragma unroll
            for (int b = 0; b < 2; ++b)
#pragma unroll
                for (int m = 0; m < 4; ++m)
#pragma unroll
                    for (int n = 0; n < 2; ++n) acc[a][b][m][n] = acc_zero;
        }
        cur = nxt; cA = nA; cB = nB; ++ui;
        if constexpr (ALIGN_EPI) { if (wr == 1) PG8_BAR; }
    }
    PG8_WAIT_V(0);
    if constexpr (!ALIGN_EPI) { if (wr == 0) PG8_BAR; }
    PG8_BAR;
    if constexpr (Epi::AFTER_DRAIN) { E.fused(acc, cur, wr, wc, fr, fq, lds, wid, lane); S.done(cur); }
#undef PG8_SA
#undef PG8_SB
#undef PG8_STAGE
#undef PG8_LDA
#undef PG8_LDB
#undef PG8_MMA
#undef PG8_WAIT_V
#undef PG8_WAIT_L
#undef PG8_BAR
#undef PG8_SCHED
}
}
namespace pg8 {
#define EPI_DRAIN() asm volatile("s_waitcnt vmcnt(0)" ::: "memory")
__device__ __forceinline__ void stage_scales(const float* lo_unit, const float* hi_unit, PG8_LAS unsigned char* buf, int wid, int lane) {
    const float* src = (wid < 4) ? lo_unit : hi_unit;
    __builtin_amdgcn_global_load_lds((const unsigned*)(src + (wid & 3) * 64 + lane), (PG8_LAS unsigned*)(buf + (wid >> 2) * 1024 + (wid & 3) * 256), 4, 0, 0);
}
template <bool I8> __device__ __forceinline__ f32x4 acc_f(const typename Mma<I8>::acc_t& a) { if constexpr (I8) return (f32x4){(float)a[0], (float)a[1], (float)a[2], (float)a[3]}; else return a; }
template <bool I8_, int LAY> struct EpiStore {
    static_assert(I8_, "scales from LDS: int8 form only");
    static constexpr bool PERM = true, AFTER_DRAIN = false, I8 = I8_, DRAINS = false; static constexpr int NST = 16, NSC = 1; typedef typename Mma<I8_>::acc_t acc_t;
    bf16_t* O; int ldc; const float* sa; const float* sw; float qscale;
    __device__ __forceinline__ void stage(const Unit& u, PG8_LAS unsigned char* buf, int wid, int lane) const { stage_scales(sw + u.pb * BM, sa + u.pm * BM, buf, wid, lane); }
    __device__ __forceinline__ void operator()(const acc_t (&acc)[2][2][4][2], const Unit& u, int wr, int wc, int fr, int fq, const PG8_LAS float* sc) const {
        const int row0 = u.pm * BM + wr * 64 + fr;
        f32x4 cs[2][2];
        if constexpr (I8) {
#pragma unroll
            for (int bj = 0; bj < 2; ++bj) { const PG8_LAS f32x4* p = (const PG8_LAS f32x4*)(sc + bj * HALF + wc * 32 + 8 * fq); cs[bj][0] = p[0]; cs[bj][1] = p[1]; } }
        float rsv[2][4];
#pragma unroll
        for (int ai = 0; ai < 2; ++ai)
#pragma unroll
            for (int m = 0; m < 4; ++m) { rsv[ai][m] = 1.f; if constexpr (I8) rsv[ai][m] = sc[256 + wr * 64 + fr + ai * HALF + m * 16]; }
        const int gj = u.pn >> 2, h0 = 4 * (u.pn & 3), b = u.pm >> 3;
        const int g = (LAY == 2) ? gj / 3 : 0, lg = (LAY == 2) ? 2 * g : 0;
        const float qs = (gj % 3 == 0) ? qscale : 1.f;
        bf16_t* const blk = O + ((size_t)(gj * 16 + b) * 16 + h0 + (wc >> 1)) * (2048 * 64) + (wc & 1) * 32 + 8 * fq;
#pragma unroll
        for (int ai = 0; ai < 2; ++ai)
#pragma unroll
            for (int m = 0; m < 4; ++m) { const int row = row0 + ai * HALF + m * 16, t = row & 2047, rp = ((t & ((1 << lg) - 1)) << (11 - lg)) + (t >> lg);
                const float rs = qs * rsv[ai][m];
#pragma unroll
                for (int bj = 0; bj < 2; ++bj) { f32x4 v0 = acc_f<I8>(acc[ai][bj][m][0]), v1 = acc_f<I8>(acc[ai][bj][m][1]);
                    if constexpr (I8) { v0 = v0 * cs[bj][0]; v1 = v1 * cs[bj][1]; }
                    v0 = v0 * rs; v1 = v1 * rs;
                    u32x4 w; w.x = cvt_pk_bf16(v0[0], v0[1]); w.y = cvt_pk_bf16(v0[2], v0[3]); w.z = cvt_pk_bf16(v1[0], v1[1]); w.w = cvt_pk_bf16(v1[2], v1[3]);
                    *(u32x4*)(blk + (size_t)bj * (2 * 2048 * 64) + (size_t)rp * 64) = w; } }
    }
};
template <bool I8_> struct EpiResid {
    static constexpr bool PERM = true, AFTER_DRAIN = false, I8 = I8_, DRAINS = true; static constexpr int NST = 16, NSC = 0; typedef typename Mma<I8_>::acc_t acc_t;
    bf16_t* H; int ldc; const float* sa; const float* sw;
    __device__ __forceinline__ void operator()(const acc_t (&acc)[2][2][4][2], const Unit& u, int wr, int wc, int fr, int fq, const PG8_LAS float* sc) const {
        const int row0 = u.pm * BM + wr * 64 + fr, col0 = u.pn * BM + wc * 32 + 8 * fq;
        f32x4 cs[2][2];
        if constexpr (I8) {
#pragma unroll
            for (int bj = 0; bj < 2; ++bj) { const f32x4* p = (const f32x4*)(sw + u.pb * BM + bj * HALF + wc * 32 + 8 * fq); cs[bj][0] = p[0]; cs[bj][1] = p[1]; } }
        float rsv[2][4];
#pragma unroll
        for (int ai = 0; ai < 2; ++ai)
#pragma unroll
            for (int m = 0; m < 4; ++m) { rsv[ai][m] = 1.f; if constexpr (I8) rsv[ai][m] = sa[row0 + ai * HALF + m * 16]; }
        EPI_DRAIN();
#pragma unroll
        for (int ai = 0; ai < 2; ++ai)
#pragma unroll
            for (int m = 0; m < 4; ++m) { const int row = row0 + ai * HALF + m * 16; bf16_t* rowp = H + (size_t)row * ldc + col0; const float rs = rsv[ai][m];
#pragma unroll
                for (int bj = 0; bj < 2; ++bj) { f32x4 v0 = acc_f<I8>(acc[ai][bj][m][0]), v1 = acc_f<I8>(acc[ai][bj][m][1]);
                    if constexpr (I8) { v0 = v0 * cs[bj][0] * rs; v1 = v1 * cs[bj][1] * rs; }
                    u32x4* hp = (u32x4*)(rowp + bj * HALF); const u32x4 o = *hp;
                    u32x4 w; w.x = cvt_pk_bf16(__uint_as_float(o.x << 16) + v0[0], __uint_as_float(o.x & 0xffff0000u) + v0[1]); w.y = cvt_pk_bf16(__uint_as_float(o.y << 16) + v0[2], __uint_as_float(o.y & 0xffff0000u) + v0[3]);
                    w.z = cvt_pk_bf16(__uint_as_float(o.z << 16) + v1[0], __uint_as_float(o.z & 0xffff0000u) + v1[1]); w.w = cvt_pk_bf16(__uint_as_float(o.w << 16) + v1[2], __uint_as_float(o.w & 0xffff0000u) + v1[3]);
                    *hp = w; } }
    }
};
template <bool I8_> struct EpiSwiGLU {
    static_assert(I8_, "scales from LDS: int8 form only");
    static constexpr bool PERM = true, AFTER_DRAIN = false, I8 = I8_, DRAINS = false; static constexpr int NST = 8, NSC = 1; typedef typename Mma<I8_>::acc_t acc_t;
    bf16_t* O; int ldc; const float* sa; const float* sw;
    __device__ __forceinline__ void stage(const Unit& u, PG8_LAS unsigned char* buf, int wid, int lane) const { stage_scales(sw + u.pb * BM, sa + u.pm * BM, buf, wid, lane); }
    static __device__ __forceinline__ float act(float g, float up) { return g * __builtin_amdgcn_rcpf(1.0f + __builtin_amdgcn_exp2f(-1.4426950408889634f * g)) * up; }
    __device__ __forceinline__ void operator()(const acc_t (&acc)[2][2][4][2], const Unit& u, int wr, int wc, int fr, int fq, const PG8_LAS float* sc) const {
        const int row0 = u.pm * BM + wr * 64 + fr, col0 = u.pn * HALF + wc * 32 + 8 * fq;
        f32x4 cs[2][2];
        if constexpr (I8) {
#pragma unroll
            for (int bj = 0; bj < 2; ++bj) { const PG8_LAS f32x4* p = (const PG8_LAS f32x4*)(sc + bj * HALF + wc * 32 + 8 * fq); cs[bj][0] = p[0]; cs[bj][1] = p[1]; } }
        float rsv[2][4];
#pragma unroll
        for (int ai = 0; ai < 2; ++ai)
#pragma unroll
            for (int m = 0; m < 4; ++m) { rsv[ai][m] = 1.f; if constexpr (I8) rsv[ai][m] = sc[256 + wr * 64 + fr + ai * HALF + m * 16]; }
#pragma unroll
        for (int ai = 0; ai < 2; ++ai)
#pragma unroll
            for (int m = 0; m < 4; ++m) { const int row = row0 + ai * HALF + m * 16; bf16_t* rowp = O + (size_t)row * ldc + col0; const float rs = rsv[ai][m];
                const float kr = -1.4426950408889634f * rs, rs2 = rs * rs;
                u32x4 w;
#pragma unroll
                for (int n = 0; n < 2; ++n) { const f32x4 ga = acc_f<I8>(acc[ai][0][m][n]), ua = acc_f<I8>(acc[ai][1][m][n]);
                    f32x4 A = ga, B = ua; if constexpr (I8) { A = ga * cs[0][n]; B = ua * cs[1][n]; }
                    const f32x4 targ = A * kr;
                    f32x4 tt; tt[0] = __builtin_amdgcn_exp2f(targ[0]); tt[1] = __builtin_amdgcn_exp2f(targ[1]); tt[2] = __builtin_amdgcn_exp2f(targ[2]); tt[3] = __builtin_amdgcn_exp2f(targ[3]);
                    const f32x4 dd = tt + 1.0f;
                    f32x4 rr; rr[0] = __builtin_amdgcn_rcpf(dd[0]); rr[1] = __builtin_amdgcn_rcpf(dd[1]); rr[2] = __builtin_amdgcn_rcpf(dd[2]); rr[3] = __builtin_amdgcn_rcpf(dd[3]);
                    const f32x4 o4 = (A * B) * (rr * rs2);
                    w[2 * n] = cvt_pk_bf16(o4[0], o4[1]); w[2 * n + 1] = cvt_pk_bf16(o4[2], o4[3]); }
                *(u32x4*)rowp = w; }
    }
};
struct EpiMoeDown {
    static constexpr bool PERM = true, AFTER_DRAIN = false, I8 = false, DRAINS = false; static constexpr int NST = 16, NSC = 1; typedef f32x4 acc_t;
    bf16_t* O; int ldc; const float* gate;
    __device__ __forceinline__ void stage(const Unit& u, PG8_LAS unsigned char* buf, int wid, int lane) const { stage_scales(gate + u.pm * BM, gate + u.pm * BM, buf, wid, lane); }
    __device__ __forceinline__ void operator()(const f32x4 (&acc)[2][2][4][2], const Unit& u, int wr, int wc, int fr, int fq, const PG8_LAS float* sc) const {
        const int row0 = u.pm * BM + wr * 64 + fr, col0 = u.pn * BM + wc * 32 + 8 * fq;
        float gtv[2][4];
#pragma unroll
        for (int ai = 0; ai < 2; ++ai)
#pragma unroll
            for (int m = 0; m < 4; ++m) gtv[ai][m] = sc[256 + wr * 64 + fr + ai * HALF + m * 16];
#pragma unroll
        for (int ai = 0; ai < 2; ++ai)
#pragma unroll
            for (int m = 0; m < 4; ++m) { const int row = row0 + ai * HALF + m * 16; const float gt = gtv[ai][m]; bf16_t* rowp = O + (size_t)row * ldc + col0;
#pragma unroll
                for (int bj = 0; bj < 2; ++bj) { const f32x4 v0 = acc[ai][bj][m][0] * gt, v1 = acc[ai][bj][m][1] * gt;
                    u32x4 w; w.x = cvt_pk_bf16(v0[0], v0[1]); w.y = cvt_pk_bf16(v0[2], v0[3]); w.z = cvt_pk_bf16(v1[0], v1[1]); w.w = cvt_pk_bf16(v1[2], v1[3]);
                    *(u32x4*)(rowp + bj * HALF) = w; } }
    }
};
}
namespace att {
typedef float f32x16 __attribute__((ext_vector_type(16)));
typedef float f32x2v __attribute__((ext_vector_type(2)));
typedef __bf16 bf16x2v __attribute__((ext_vector_type(2)));
typedef short bf16x8 __attribute__((ext_vector_type(8)));
typedef unsigned u32x4 __attribute__((ext_vector_type(4)));
typedef unsigned u32x2 __attribute__((ext_vector_type(2)));
typedef unsigned short bf16;
#define ATT_LAS __attribute__((address_space(3)))
constexpr float LOG2E = 1.4426950408889634f, LN2 = 0.6931471805599453f;
constexpr float SB_CUT = 25.0f, SB_CUT2 = 25.0f * 1.4426950408889634f;
__device__ __forceinline__ int crow(int r, int hi) { return (r & 3) + 8 * (r >> 2) + 4 * hi; }
__device__ __forceinline__ unsigned cvtpk(float lo, float hi) { f32x2v v = {lo, hi}; bf16x2v b = __builtin_convertvector(v, bf16x2v); return __builtin_bit_cast(unsigned, b); }

__device__ __forceinline__ float xmax32(float v) { auto r = __builtin_amdgcn_permlane32_swap(__float_as_uint(v), __float_as_uint(v), false, false); return fmaxf(__uint_as_float(r[0]), __uint_as_float(r[1])); }
__device__ __forceinline__ float xsum32(float v) { auto r = __builtin_amdgcn_permlane32_swap(__float_as_uint(v), __float_as_uint(v), false, false); return __uint_as_float(r[0]) + __uint_as_float(r[1]); }
__device__ __forceinline__ void load_rowfrags(bf16x8 (&f)[4], const bf16* rowbase  , int hh) {
#pragma unroll
    for (int ks = 0; ks < 4; ++ks) f[ks] = *(const bf16x8*)(rowbase + ks * 16 + hh * 8);
}
__device__ __forceinline__ f32x16 qk_tile(const bf16x8 (&kf)[4], const bf16x8 (&qf)[4]) {
    f32x16 s = {};
#pragma unroll
    for (int ks = 0; ks < 4; ++ks) s = __builtin_amdgcn_mfma_f32_32x32x16_bf16(kf[ks], qf[ks], s, 0, 0, 0);
    return s;
}
constexpr int VT_HALF = 2048;
constexpr int VT_BYTES = 2 * VT_HALF;
typedef short v4i16_t __attribute__((ext_vector_type(4)));
__device__ __forceinline__ u32x2 vtr(const ATT_LAS unsigned char* p) { return __builtin_bit_cast(u32x2, __builtin_amdgcn_ds_read_tr16_b64_v4i16((ATT_LAS v4i16_t*)p)); }
__device__ __forceinline__ void pv_tile(f32x16 (&o)[2], const f32x16& p, const ATT_LAS unsigned char* vt, int lane) {
    const int hh = lane >> 5, i16 = lane & 15;
    bf16x8 pb[2];
#pragma unroll
    for (int s = 0; s < 2; ++s) { u32x4 w; w.x = cvtpk(p[8 * s + 0], p[8 * s + 1]); w.y = cvtpk(p[8 * s + 2], p[8 * s + 3]); w.z = cvtpk(p[8 * s + 4], p[8 * s + 5]); w.w = cvtpk(p[8 * s + 6], p[8 * s + 7]); pb[s] = __builtin_bit_cast(bf16x8, w); }
    const ATT_LAS unsigned char* rb = vt + (4 * hh + (i16 >> 2)) * 64 + ((lane >> 4) & 1) * 32 + (i16 & 3) * 8;
#pragma unroll
    for (int db = 0; db < 2; ++db)
#pragma unroll
        for (int s = 0; s < 2; ++s) {
            const u32x2 lo = vtr(rb + db * VT_HALF + (16 * s) * 64), hi = vtr(rb + db * VT_HALF + (16 * s + 8) * 64);
            u32x4 a; a.x = lo.x; a.y = lo.y; a.z = hi.x; a.w = hi.y;
            o[db] = __builtin_amdgcn_mfma_f32_32x32x16_bf16(__builtin_bit_cast(bf16x8, a), pb[s], o[db], 0, 0, 0);
        }
}
__device__ __forceinline__ void pv_load(u32x2 (&vr)[2][2][2], const ATT_LAS unsigned char* vt, int lane) {
    const int hh = lane >> 5, i16 = lane & 15;
    const ATT_LAS unsigned char* rb = vt + (4 * hh + (i16 >> 2)) * 64 + ((lane >> 4) & 1) * 32 + (i16 & 3) * 8;
#pragma unroll
    for (int db = 0; db < 2; ++db)
#pragma unroll
        for (int s = 0; s < 2; ++s) { vr[db][s][0] = vtr(rb + db * VT_HALF + (16 * s) * 64); vr[db][s][1] = vtr(rb + db * VT_HALF + (16 * s + 8) * 64); }
}
__device__ __forceinline__ void pv_mma(f32x16 (&o)[2], const f32x16& p, const u32x2 (&vr)[2][2][2]) {
    bf16x8 pb[2];
#pragma unroll
    for (int s = 0; s < 2; ++s) { u32x4 w; w.x = cvtpk(p[8 * s + 0], p[8 * s + 1]); w.y = cvtpk(p[8 * s + 2], p[8 * s + 3]); w.z = cvtpk(p[8 * s + 4], p[8 * s + 5]); w.w = cvtpk(p[8 * s + 6], p[8 * s + 7]); pb[s] = __builtin_bit_cast(bf16x8, w); }
#pragma unroll
    for (int db = 0; db < 2; ++db)
#pragma unroll
        for (int s = 0; s < 2; ++s) { u32x4 av; av.x = vr[db][s][0].x; av.y = vr[db][s][0].y; av.z = vr[db][s][1].x; av.w = vr[db][s][1].y;
            o[db] = __builtin_amdgcn_mfma_f32_32x32x16_bf16(__builtin_bit_cast(bf16x8, av), pb[s], o[db], 0, 0, 0); }
}
__device__ __forceinline__ void store_ot(bf16* orow  , const f32x16 (&o)[2], float scale, int hh) {
#pragma unroll
    for (int db = 0; db < 2; ++db)
#pragma unroll
        for (int q = 0; q < 4; q += 2) {
            unsigned ax = cvtpk(o[db][4 * q] * scale, o[db][4 * q + 1] * scale), ay = cvtpk(o[db][4 * q + 2] * scale, o[db][4 * q + 3] * scale);
            unsigned bx = cvtpk(o[db][4 * q + 4] * scale, o[db][4 * q + 5] * scale), by = cvtpk(o[db][4 * q + 6] * scale, o[db][4 * q + 7] * scale);
            { auto r = __builtin_amdgcn_permlane32_swap(ax, bx, false, false); ax = r[0]; bx = r[1]; }
            { auto r = __builtin_amdgcn_permlane32_swap(ay, by, false, false); ay = r[0]; by = r[1]; }
            u32x4 w; w.x = ax; w.y = ay; w.z = bx; w.w = by;
            *(u32x4*)(orow + db * 32 + 8 * (q + hh)) = w; }
}

template <int BIAS> __device__ __forceinline__ unsigned pack8x4q(float a, float b, float c, float d, float scale) {
    typedef float f2_ __attribute__((ext_vector_type(2)));
    const f2_ s2 = {scale, scale}, m2 = {12582912.0f + (float)BIAS, 12582912.0f + (float)BIAS};
    const f2_ p = __builtin_elementwise_fma((f2_){a, b}, s2, m2), q = __builtin_elementwise_fma((f2_){c, d}, s2, m2);
    return __builtin_amdgcn_perm(__float_as_uint(p.y), __float_as_uint(p.x), 0x0c0c0400u) | __builtin_amdgcn_perm(__float_as_uint(q.y), __float_as_uint(q.x), 0x04000c0cu);
}
__device__ __forceinline__ void store_ot8(unsigned char* orow  , const f32x16 (&o)[2], float scale, int hh) {
#pragma unroll
    for (int db = 0; db < 2; ++db) {
        unsigned dq[4];
#pragma unroll
        for (int q = 0; q < 4; ++q) dq[q] = pack8x4q<128>(o[db][4 * q], o[db][4 * q + 1], o[db][4 * q + 2], o[db][4 * q + 3], scale);
        u32x4 w;
        { auto r = __builtin_amdgcn_permlane32_swap(dq[0], dq[2], false, false); w.x = r[0]; w.y = r[1]; }
        { auto r = __builtin_amdgcn_permlane32_swap(dq[1], dq[3], false, false); w.z = r[0]; w.w = r[1]; }
        *(u32x4*)(orow + db * 32 + 16 * hh) = w; }
}

struct DilOut { u32x4 w[2]; unsigned char* p; unsigned ix; float lse, osc; };
__device__ __forceinline__ void pack_ot8(DilOut& t, const f32x16 (&o)[2], float scale) {
#pragma unroll
    for (int db = 0; db < 2; ++db) {
        unsigned dq[4];
#pragma unroll
        for (int q = 0; q < 4; ++q) dq[q] = pack8x4q<128>(o[db][4 * q], o[db][4 * q + 1], o[db][4 * q + 2], o[db][4 * q + 3], scale);
        { auto r = __builtin_amdgcn_permlane32_swap(dq[0], dq[2], false, false); t.w[db].x = r[0]; t.w[db].y = r[1]; }
        { auto r = __builtin_amdgcn_permlane32_swap(dq[1], dq[3], false, false); t.w[db].z = r[0]; t.w[db].w = r[1]; } }
}
__device__ __forceinline__ void dil2_flush(const DilOut& t, float* lse_all, float* osc_all, int lane) {
    const int hh = lane >> 5;
    *(u32x4*)(t.p + 16 * hh) = t.w[0]; *(u32x4*)(t.p + 32 + 16 * hh) = t.w[1];
    if (hh == 0) { lse_all[t.ix] = t.lse; osc_all[t.ix] = t.osc; }
}
constexpr int KV_SLOT = 4096 + VT_BYTES;
#ifndef SB_TEST_TRUNC
#define SB_TEST_TRUNC 0
#endif
struct DilUnit { const bf16* qbase; int row0, nslots, smin, dil, g, bh; };
__device__ __forceinline__ DilUnit dil_unit(const bf16* qkv, int U) {
    constexpr size_t HB = (size_t)2048 * 64, JB = 256 * HB;
    DilUnit d; d.bh = U / 24; const int rem = U - d.bh * 24; d.g = rem >> 3; const int uu = rem & 7;
    d.qbase = qkv + (size_t)(d.g * 3) * JB + (size_t)d.bh * HB;
    if (d.g == 2) { d.dil = 16; d.row0 = uu * 256; d.nslots = 8; d.smin = 0; }
    else { d.dil = (d.g == 0) ? 1 : 4; const int res = (d.g == 0) ? 0 : (uu >> 1), c = (d.g == 0) ? uu : (uu & 1), L = 2048 / d.dil; d.row0 = res * L + 32 * (8 * c - 4); d.nslots = 12; d.smin = (c == 0) ? 4 : 0; }
    return d;
}
struct DilRegs { u32x4 kv[12]; bf16x8 q[4]; };
__device__ __forceinline__ void dil_wave(const DilUnit& d, int wave, int& qrow0, int& s_first, int& nst) {
    if (d.g == 2) { qrow0 = d.row0 + wave * 32; s_first = (wave >> 2) * 4; nst = (wave & 3) + 1; }
    else { qrow0 = d.row0 + 32 * (4 + wave); s_first = wave; nst = 5; if (s_first < d.smin) { nst -= d.smin - s_first; s_first = d.smin; } }
}
__device__ __forceinline__ void dil_issue(DilRegs& r, const DilUnit& d, int tid, int wave, int lane) {
    constexpr size_t JB = (size_t)256 * 2048 * 64;
    const int hs = tid >> 8, key = (tid & 255) >> 3, chunk = tid & 7;
#pragma unroll
    for (int i = 0; i < 12; ++i) { const int s = 2 * (i % 6) + hs;
        if (s >= d.smin && s < d.nslots) r.kv[i] = *(const u32x4*)(d.qbase + (i < 6 ? JB : 2 * JB) + (size_t)(d.row0 + 32 * s + key) * 64 + chunk * 8); }
    int qrow0, s_first, nst; dil_wave(d, wave, qrow0, s_first, nst);
    load_rowfrags(r.q, d.qbase + (size_t)(qrow0 + (lane & 31)) * 64, lane >> 5);
}
__device__ __forceinline__ void dil_write(ATT_LAS unsigned char* ring, const DilRegs& r, const DilUnit& d, int tid) {
    const int hs = tid >> 8, key = (tid & 255) >> 3, chunk = tid & 7;
#pragma unroll
    for (int i = 0; i < 12; ++i) { const int s = 2 * (i % 6) + hs;
        ATT_LAS unsigned char* p = ring + s * KV_SLOT + (i < 6 ? key * 128 + ((chunk ^ ((key >> 1) & 7)) * 16) : 4096 + (chunk >> 2) * VT_HALF + key * 64 + (chunk & 3) * 16);
        if (s >= d.smin && s < d.nslots) *(ATT_LAS u32x4*)p = r.kv[i]; }
}
struct Dil2Unit { const bf16* qbase; int rowc, c, dil, g, bh; };
__device__ __forceinline__ Dil2Unit dil2_unit(const bf16* qkv, int P, int e) {
    constexpr size_t HB = (size_t)2048 * 64, JB = 256 * HB;
    Dil2Unit d; d.bh = P / 3; d.g = P - 3 * d.bh;
    d.qbase = qkv + (size_t)(d.g * 3) * JB + (size_t)d.bh * HB;
    if (d.g == 0) { d.dil = 1; d.rowc = 0; d.c = e; }
    else if (d.g == 1) { d.dil = 4; d.rowc = (e >> 1) * 512; d.c = e & 1; }
    else { d.dil = 16; d.rowc = e * 256; d.c = 0; }
    return d;
}
struct Dil2Regs { u32x4 kv[8]; bf16x8 q[4]; };
__device__ __forceinline__ void dil2_issue(Dil2Regs& r, const Dil2Unit& d, int tid, int wave, int lane) {
    constexpr size_t JB = (size_t)256 * 2048 * 64;
    const int hs = tid >> 8, key = (tid & 255) >> 3, chunk = tid & 7;
#pragma unroll
    for (int i = 0; i < 8; ++i) { const int sl = 2 * (i & 3) + hs;
        r.kv[i] = *(const u32x4*)(d.qbase + (i < 4 ? JB : 2 * JB) + (size_t)(d.rowc + 32 * (8 * d.c + sl) + key) * 64 + chunk * 8); }
    load_rowfrags(r.q, d.qbase + (size_t)(d.rowc + 32 * (8 * d.c + wave) + (lane & 31)) * 64, lane >> 5);
}
__device__ __forceinline__ void dil2_write(ATT_LAS unsigned char* ring, const Dil2Regs& r, const Dil2Unit& d, int tid) {
    const int hs = tid >> 8, key = (tid & 255) >> 3, chunk = tid & 7;
#pragma unroll
    for (int i = 0; i < 8; ++i) { const int sl = 2 * (i & 3) + hs, s = (8 * d.c + sl) & 15;
        ATT_LAS unsigned char* p = ring + s * KV_SLOT + (i < 4 ? key * 128 + ((chunk ^ ((key >> 1) & 7)) * 16) : 4096 + (chunk >> 2) * VT_HALF + key * 64 + (chunk & 3) * 16);
        *(ATT_LAS u32x4*)p = r.kv[i]; }
}
__device__ __forceinline__ void dil2_compute(const ATT_LAS unsigned char* ring, const Dil2Unit& d, const bf16x8 (&qf)[4], unsigned char* og_all, DilOut& out, int wave, int lane) {
    const int r32 = lane & 31, hh = lane >> 5, h = d.bh & 15, b = d.bh >> 4;
    const int qt = (d.g == 2) ? (wave & 3) : 8 * d.c + wave, kt_lo = (qt - 4 < 0) ? 0 : qt - 4, sbase = (d.g == 2) ? 4 * (wave >> 2) : 0;
    const float slope2 = __builtin_amdgcn_exp2f(-0.5f * (float)(h + 1)) * (float)d.dil * LOG2E;
    float m = -1e30f, l = 0.f; f32x16 o[2]; o[0] = f32x16{}; o[1] = f32x16{};
    f32x16 cb;
#pragma unroll
    for (int r = 0; r < 16; ++r) cb[r] = slope2 * (float)crow(r, hh);
#define DIL2_QK(dst, kt_) do { const ATT_LAS unsigned char* sl_ = ring + ((sbase + (kt_)) & 15) * KV_SLOT; bf16x8 kf_[4]; \
        _Pragma("unroll") for (int ks = 0; ks < 4; ++ks) kf_[ks] = *(const ATT_LAS bf16x8*)(sl_ + r32 * 128 + (((2 * ks + hh) ^ ((r32 >> 1) & 7)) * 16)); \
        const float tb_ = -slope2 * (float)(32 * (qt - (kt_)) + r32); \
        dst = cb + tb_;     \
        __builtin_amdgcn_sched_barrier(0); \
        _Pragma("unroll") for (int ks = 0; ks < 4; ++ks) dst = __builtin_amdgcn_mfma_f32_32x32x16_bf16(kf_[ks], qf[ks], dst, 0, 0, 0); } while (0)
    f32x16 sn; DIL2_QK(sn, kt_lo);
    for (int kt = kt_lo; kt <= qt; ++kt) {
        const ATT_LAS unsigned char* slot = ring + ((sbase + kt) & 15) * KV_SLOT;
        f32x16 sc = sn;
        u32x2 vr[2][2][2]; pv_load(vr, slot + 4096, lane);
        if (kt < qt) DIL2_QK(sn, kt + 1);
        __builtin_amdgcn_sched_barrier(0);
        const bool edge = (kt == kt_lo) || (kt == qt);
        if (edge) {
            asm volatile("" ::: "memory");
            const int relb = 32 * (qt - kt) + r32;
#pragma unroll
            for (int r = 0; r < 16; ++r) { const int rel = relb - crow(r, hh); if (!((rel >= 0) && (rel <= 128))) sc[r] = -3.0e38f; }
        }
        float mt = -1e30f;
#pragma unroll
        for (int r = 0; r < 16; ++r) mt = fmaxf(mt, sc[r]);
        mt = xmax32(mt);
        const float mn = (mt - m > 8.0f) ? mt : m, alpha = __builtin_amdgcn_exp2f(m - mn); m = mn;
        { const float nmn = -mn; sc = sc + nmn; }
#pragma unroll
        for (int r = 0; r < 16; ++r) sc[r] = __builtin_amdgcn_exp2f(sc[r]);
        float ps;
        { typedef float f32x8v __attribute__((ext_vector_type(8))); typedef float f32x4v __attribute__((ext_vector_type(4)));
          const f32x8v s8 = __builtin_shufflevector(sc, sc, 0, 1, 2, 3, 4, 5, 6, 7) + __builtin_shufflevector(sc, sc, 8, 9, 10, 11, 12, 13, 14, 15);
          const f32x4v s4 = __builtin_shufflevector(s8, s8, 0, 1, 2, 3) + __builtin_shufflevector(s8, s8, 4, 5, 6, 7);
          const f32x2v s2 = __builtin_shufflevector(s4, s4, 0, 1) + __builtin_shufflevector(s4, s4, 2, 3);
          ps = s2.x + s2.y; }
        l = l * alpha + ps;
        if (__any(alpha != 1.0f)) {
#pragma unroll
            for (int r = 0; r < 16; ++r) { o[0][r] *= alpha; o[1][r] *= alpha; } }
        pv_mma(o, sc, vr);
    }
#undef DIL2_QK
    l = xsum32(l);
    const int rowp = d.rowc + 32 * ((d.g == 2) ? wave : qt) + r32, L = 2048 / d.dil, res = rowp / L, lsub = rowp - res * L;
    const size_t tok = (size_t)b * 2048 + (size_t)lsub * d.dil + res;
    float am = 0.f;
#pragma unroll
    for (int r = 0; r < 16; ++r) am = fmaxf(am, fmaxf(fabsf(o[0][r]), fabsf(o[1][r])));
    am = xmax32(am);
    pack_ot8(out, o, am > 0.f ? 127.0f * __builtin_amdgcn_rcpf(am) : 0.f);
    out.p = og_all + ((size_t)(d.g * 256 + d.bh) * 2048 + rowp) * 64;
    float kln2 = LN2, k127 = 1.0f / 127.0f; asm volatile("" : "+v"(kln2), "+v"(k127));
    out.ix = (unsigned)((size_t)d.g * (32768 * 16) + tok * 16 + h); out.lse = (m + __builtin_amdgcn_logf(l)) * kln2; out.osc = am * k127 * __builtin_amdgcn_rcpf(l);
}
__device__ __forceinline__ void dilated_phase2(const bf16* qkv, unsigned char* og_all, float* lse_all, float* osc_all, ATT_LAS unsigned char* ring, int vcu, int G, int tid, int wave, int lane) {
    constexpr int NP = 256 * 3;
    if (vcu >= NP) return;
    int P = vcu, e = 0;
    Dil2Regs r; Dil2Unit d = dil2_unit(qkv, P, e);
    DilOut pend; bool havep = false;
    dil2_issue(r, d, tid, wave, lane);
    for (;;) {
        dil2_write(ring, r, d, tid);
        bf16x8 qf[4];
#pragma unroll
        for (int ks = 0; ks < 4; ++ks) qf[ks] = r.q[ks];
        asm volatile("" : "+v"(qf[0]), "+v"(qf[1]), "+v"(qf[2]), "+v"(qf[3]));
        asm volatile("s_waitcnt vmcnt(0)" ::: "memory");
        __syncthreads();
        if (havep) dil2_flush(pend, lse_all, osc_all, lane);
        int Pn = P, en = e + 1; if (en == 8) { en = 0; Pn = P + G; }
        const bool more = Pn < NP; const Dil2Unit dn = dil2_unit(qkv, more ? Pn : P, more ? en : e);
        if (more) dil2_issue(r, dn, tid, wave, lane);
        dil2_compute(ring, d, qf, og_all, pend, wave, lane); havep = true;
        __syncthreads();
        if (!more) break;
        P = Pn; e = en; d = dn;
    }
    dil2_flush(pend, lse_all, osc_all, lane);
}

struct CombRow { u32x4 a, b, c; float l0, l1, l2, s0, s1, s2; };
__device__ __forceinline__ void comb_load(CombRow& r, const unsigned char* og_all, const float* lse_all, const float* osc_all, int m, int lane) {
    const size_t th = (size_t)m * 16 + (lane >> 2), G1 = (size_t)32768 * 16, E1 = (size_t)32768 * 1024;
    r.l0 = lse_all[th]; r.l1 = lse_all[G1 + th]; r.l2 = lse_all[2 * G1 + th];
    r.s0 = osc_all[th]; r.s1 = osc_all[G1 + th]; r.s2 = osc_all[2 * G1 + th];
    const int bb = m >> 11, tt = m & 2047, hd = lane >> 2;
    const unsigned char* p = og_all + ((size_t)(bb * 16 + hd) * 2048) * 64 + (lane & 3) * 16;
    r.a = *(const u32x4*)(p + (size_t)tt * 64);
    r.b = *(const u32x4*)(p + E1 + (size_t)(((tt & 3) << 9) + (tt >> 2)) * 64);
    r.c = *(const u32x4*)(p + 2 * E1 + (size_t)(((tt & 15) << 7) + (tt >> 4)) * 64);
}
__device__ __forceinline__ void comb_finish(const CombRow& r, unsigned char* y8, float* sa, int m, int lane) {
    const float mx = fmaxf(r.l0, fmaxf(r.l1, r.l2)), e0 = __expf(r.l0 - mx), e1 = __expf(r.l1 - mx), e2 = __expf(r.l2 - mx), inv = __builtin_amdgcn_rcpf(e0 + e1 + e2);
    float kn = -128.0f; asm volatile("" : "+v"(kn));
    const float w0 = e0 * inv * r.s0, w1 = e1 * inv * r.s1, w2 = e2 * inv * r.s2, c0 = kn * (w0 + w1 + w2);
    float y[16]; float am = 0.f;
    { typedef float f2_ __attribute__((ext_vector_type(2)));
      const f2_ w0v = {w0, w0}, w1v = {w1, w1}, w2v = {w2, w2}, c0v = {c0, c0};
#pragma unroll
      for (int k = 0; k < 4; ++k)
#pragma unroll
        for (int j = 0; j < 4; j += 2) {
            const f2_ a2 = {(float)((r.a[k] >> (8 * j)) & 0xffu), (float)((r.a[k] >> (8 * j + 8)) & 0xffu)}, b2 = {(float)((r.b[k] >> (8 * j)) & 0xffu), (float)((r.b[k] >> (8 * j + 8)) & 0xffu)},
                      c2 = {(float)((r.c[k] >> (8 * j)) & 0xffu), (float)((r.c[k] >> (8 * j + 8)) & 0xffu)};
            const f2_ v = __builtin_elementwise_fma(w0v, a2, __builtin_elementwise_fma(w1v, b2, __builtin_elementwise_fma(w2v, c2, c0v)));
            y[4 * k + j] = v.x; y[4 * k + j + 1] = v.y; am = fmaxf(am, fmaxf(fabsf(v.x), fabsf(v.y))); } }
    am = wave_max(am);
    const float q = am > 0.f ? 127.0f * __builtin_amdgcn_rcpf(am) : 0.f;
    u32x4 out;
#pragma unroll
    for (int k = 0; k < 4; ++k) out[k] = pack8x4q<0>(y[4 * k], y[4 * k + 1], y[4 * k + 2], y[4 * k + 3], q);
    *(u32x4*)(y8 + (size_t)m * 1024 + lane * 16) = out;
    if (lane == 0) sa[m] = am * (1.0f / (127.0f * 127.0f));
}
__device__ __forceinline__ void dilated_combine_2rows(const unsigned char* og_all, const float* lse_all, const float* osc_all, unsigned char* y8, float* sa, int m0, int m1, int lane) {
    const bool two = m1 < 32768;
    CombRow ra, rb; comb_load(ra, og_all, lse_all, osc_all, m0, lane); comb_load(rb, og_all, lse_all, osc_all, two ? m1 : m0, lane);
    comb_finish(ra, y8, sa, m0, lane);
    if (two) comb_finish(rb, y8, sa, m1, lane);
}

__device__ __forceinline__ DilUnit sb_unit(const bf16* qkv, int bh, int sub) {
    DilUnit d; d.bh = bh; d.g = 0; d.dil = 1; d.qbase = qkv + (size_t)bh * ((size_t)2048 * 64); d.row0 = 32 * (8 * sub - 4); d.nslots = 12; d.smin = (sub == 0) ? 4 : 0; return d;
}
constexpr float SB_CUTP = 1.3887943864964021e-11f;
template <bool DIAG> __device__ __forceinline__ void sb_math(float& Rp, f32x16& z, int lane) {
    const int r32 = lane & 31, hh = lane >> 5;
    f32x16 e2, om;
#pragma unroll
    for (int r = 0; r < 16; ++r) e2[r] = __builtin_amdgcn_exp2f(z[r]);
    const f32x16 dd = e2 + 1.0f;
#pragma unroll
    for (int r = 0; r < 16; ++r) om[r] = __builtin_amdgcn_rcpf(dd[r]);
    f32x16 be; { const f32x16 nom = -om; be = nom + 1.0f; }
    if (DIAG) {
#pragma unroll
        for (int r = 0; r < 16; ++r) { const bool valid = crow(r, hh) < r32; om[r] = valid ? om[r] : 1.0f; be[r] = valid ? be[r] : 0.f; } }
    float glo[4], ghi[4];
#pragma unroll
    for (int i = 0; i < 4; ++i) { const float g = (om[4 * i] * om[4 * i + 1]) * (om[4 * i + 2] * om[4 * i + 3]);
        auto r = __builtin_amdgcn_permlane32_swap(__float_as_uint(g), __float_as_uint(g), false, false); glo[i] = __uint_as_float(r[0]); ghi[i] = __uint_as_float(r[1]); }
    float qq = Rp;
#pragma unroll
    for (int i = 3; i >= 0; --i) {
        const float c3 = (hh == 0) ? qq * ghi[i] : qq;
        const float c2 = c3 * om[4 * i + 3], c1 = c2 * om[4 * i + 2], c0 = c1 * om[4 * i + 1];
        z[4 * i] = be[4 * i] * c0; z[4 * i + 1] = be[4 * i + 1] * c1; z[4 * i + 2] = be[4 * i + 2] * c2; z[4 * i + 3] = be[4 * i + 3] * c3;
        qq *= glo[i] * ghi[i];
    }
    Rp = qq;
}
__device__ __forceinline__ void sb_compute(const ATT_LAS unsigned char* ring, const DilUnit& d, int sub, const bf16x8 (&qf)[4], bf16* y, int wave, int lane) {
    const int r32 = lane & 31, hh = lane >> 5, h = d.bh & 15, b = d.bh >> 4, qt = 8 * sub + wave;
    float R = 1.0f; f32x16 o[2]; o[0] = f32x16{}; o[1] = f32x16{};
    bool done = false;
    { const ATT_LAS unsigned char* slot = ring + (wave + 4) * KV_SLOT;
        bf16x8 kf[4];
#pragma unroll
        for (int ks = 0; ks < 4; ++ks) kf[ks] = *(const ATT_LAS bf16x8*)(slot + r32 * 128 + (((2 * ks + hh) ^ ((r32 >> 1) & 7)) * 16));
        f32x16 z = qk_tile(kf, qf);
        sb_math<true>(R, z, lane);
        pv_tile(o, z, slot + 4096, lane);
        done = __all(R < SB_CUTP); }
    int kt_next = qt - 1;
    if (!done) for (int s = wave + 3; s >= d.smin + SB_TEST_TRUNC; --s) {
        const ATT_LAS unsigned char* slot = ring + s * KV_SLOT;
        bf16x8 kf[4];
#pragma unroll
        for (int ks = 0; ks < 4; ++ks) kf[ks] = *(const ATT_LAS bf16x8*)(slot + r32 * 128 + (((2 * ks + hh) ^ ((r32 >> 1) & 7)) * 16));
        f32x16 z = qk_tile(kf, qf);
        sb_math<false>(R, z, lane);
        pv_tile(o, z, slot + 4096, lane);
        kt_next = 8 * sub - 4 + s - 1;
        if (__all(R < SB_CUTP)) { done = true; break; }
    }
    if (!done && kt_next >= 0) {
        constexpr size_t JB = (size_t)256 * 2048 * 64;
        for (int kt = kt_next; kt >= 0; --kt) {
            bf16x8 kf[4]; load_rowfrags(kf, d.qbase + JB + (size_t)(32 * kt + r32) * 64, hh);
            f32x16 z = qk_tile(kf, qf);
            sb_math<false>(R, z, lane);
            bf16x8 pb[2];
#pragma unroll
            for (int s = 0; s < 2; ++s) { u32x4 w; w.x = cvtpk(z[8 * s + 0], z[8 * s + 1]); w.y = cvtpk(z[8 * s + 2], z[8 * s + 3]); w.z = cvtpk(z[8 * s + 4], z[8 * s + 5]); w.w = cvtpk(z[8 * s + 6], z[8 * s + 7]); pb[s] = __builtin_bit_cast(bf16x8, w); }
            const bf16* vb = d.qbase + 2 * JB + (size_t)(32 * kt) * 64;
#pragma unroll
            for (int db = 0; db < 2; ++db)
#pragma unroll
                for (int s = 0; s < 2; ++s) { u32x4 a;
#pragma unroll
                    for (int j2 = 0; j2 < 4; ++j2) { const int k0 = 16 * s + 8 * ((2 * j2) >> 2) + 4 * hh + ((2 * j2) & 3), k1 = k0 + 1;
                        a[j2] = (unsigned)vb[(size_t)k0 * 64 + db * 32 + r32] | ((unsigned)vb[(size_t)k1 * 64 + db * 32 + r32] << 16); }
                    o[db] = __builtin_amdgcn_mfma_f32_32x32x16_bf16(__builtin_bit_cast(bf16x8, a), pb[s], o[db], 0, 0, 0); }
            if (__all(R < SB_CUTP)) break;
        }
    }
    store_ot(y + ((size_t)b * 2048 + 32 * qt + r32) * 1024 + h * 64, o, 1.0f, hh);
}
__device__ __forceinline__ void sb_phase(const bf16* qkv, bf16* y, ATT_LAS unsigned char* ring, int vcu, int G, int tid, int wave, int lane) {
    int k = 0; if (vcu >= 2048) return;
    int U = vcu, sub = (U & 7);
    DilRegs r; DilUnit d = sb_unit(qkv, U >> 3, sub);
    dil_issue(r, d, tid, wave, lane);
    for (;;) {
        dil_write(ring, r, d, tid);
        bf16x8 qf[4];
#pragma unroll
        for (int ks = 0; ks < 4; ++ks) qf[ks] = r.q[ks];
        __syncthreads();
        const int Un = U + G, kn = k + 1, subn = ((Un & 7) + kn) & 7; const DilUnit dn = sb_unit(qkv, (Un < 2048 ? Un : U) >> 3, subn);
        if (Un < 2048) dil_issue(r, dn, tid, wave, lane);
        sb_compute(ring, d, sub, qf, y, wave, lane);
        __syncthreads();
        if (Un >= 2048) break;
        U = Un; k = kn; sub = subn; d = dn;
    }
}

__device__ __forceinline__ Dil2Unit sb2_unit(const bf16* qkv, int bh, int c) { Dil2Unit d; d.bh = bh; d.g = 0; d.dil = 1; d.rowc = 0; d.c = c; d.qbase = qkv + (size_t)bh * ((size_t)2048 * 64); return d; }
__device__ __forceinline__ void sb_compute2(const ATT_LAS unsigned char* ring, const Dil2Unit& d, const bf16x8 (&qf)[4], bf16* y, int wave, int lane) {
    const int r32 = lane & 31, hh = lane >> 5, h = d.bh & 15, b = d.bh >> 4, qt = 8 * d.c + wave;
    const int lo = (8 * d.c - 8 < 0) ? 0 : 8 * d.c - 8;
    float R = 1.0f; f32x16 o[2]; o[0] = f32x16{}; o[1] = f32x16{};
    bool done = false;
    { const ATT_LAS unsigned char* slot = ring + (qt & 15) * KV_SLOT;
        bf16x8 kf[4];
#pragma unroll
        for (int ks = 0; ks < 4; ++ks) kf[ks] = *(const ATT_LAS bf16x8*)(slot + r32 * 128 + (((2 * ks + hh) ^ ((r32 >> 1) & 7)) * 16));
        f32x16 z = qk_tile(kf, qf);
        sb_math<true>(R, z, lane);
        pv_tile(o, z, slot + 4096, lane);
        done = __all(R < SB_CUTP); }
    int kt = qt - 1;
    if (!done) for (; kt >= lo; --kt) {
        const ATT_LAS unsigned char* slot = ring + (kt & 15) * KV_SLOT;
        bf16x8 kf[4];
#pragma unroll
        for (int ks = 0; ks < 4; ++ks) kf[ks] = *(const ATT_LAS bf16x8*)(slot + r32 * 128 + (((2 * ks + hh) ^ ((r32 >> 1) & 7)) * 16));
        f32x16 z = qk_tile(kf, qf);
        sb_math<false>(R, z, lane);
        pv_tile(o, z, slot + 4096, lane);
        if (__all(R < SB_CUTP)) { done = true; break; }
    }
    if (!done && kt >= 0) {
        constexpr size_t JB = (size_t)256 * 2048 * 64;
        for (; kt >= 0; --kt) {
            bf16x8 kf[4]; load_rowfrags(kf, d.qbase + JB + (size_t)(32 * kt + r32) * 64, hh);
            f32x16 z = qk_tile(kf, qf);
            sb_math<false>(R, z, lane);
            bf16x8 pb[2];
#pragma unroll
            for (int s = 0; s < 2; ++s) { u32x4 w; w.x = cvtpk(z[8 * s + 0], z[8 * s + 1]); w.y = cvtpk(z[8 * s + 2], z[8 * s + 3]); w.z = cvtpk(z[8 * s + 4], z[8 * s + 5]); w.w = cvtpk(z[8 * s + 6], z[8 * s + 7]); pb[s] = __builtin_bit_cast(bf16x8, w); }
            const bf16* vb = d.qbase + 2 * JB + (size_t)(32 * kt) * 64;
#pragma unroll
            for (int db = 0; db < 2; ++db)
#pragma unroll
                for (int s = 0; s < 2; ++s) { u32x4 av;
#pragma unroll
                    for (int j2 = 0; j2 < 4; ++j2) { const int k0 = 16 * s + 8 * ((2 * j2) >> 2) + 4 * hh + ((2 * j2) & 3), k1 = k0 + 1;
                        av[j2] = (unsigned)vb[(size_t)k0 * 64 + db * 32 + r32] | ((unsigned)vb[(size_t)k1 * 64 + db * 32 + r32] << 16); }
                    o[db] = __builtin_amdgcn_mfma_f32_32x32x16_bf16(__builtin_bit_cast(bf16x8, av), pb[s], o[db], 0, 0, 0); }
            if (__all(R < SB_CUTP)) break;
        }
    }
    store_ot(y + ((size_t)b * 2048 + 32 * qt + r32) * 1024 + h * 64, o, 1.0f, hh);
}
__device__ __forceinline__ void sb_phase2(const bf16* qkv, bf16* y, ATT_LAS unsigned char* ring, int vcu, int G, int tid, int wave, int lane) {
    constexpr int NCH = 256;
    if (vcu >= NCH) return;
    int P = vcu, e = 0;
    Dil2Regs r; Dil2Unit d = sb2_unit(qkv, P, e);
    dil2_issue(r, d, tid, wave, lane);
    for (;;) {
        dil2_write(ring, r, d, tid);
        bf16x8 qf[4];
#pragma unroll
        for (int ks = 0; ks < 4; ++ks) qf[ks] = r.q[ks];
        __syncthreads();
        int Pn = P, en = e + 1; if (en == 8) { en = 0; Pn = P + G; }
        const bool more = Pn < NCH; const Dil2Unit dn = sb2_unit(qkv, more ? Pn : P, more ? en : e);
        if (more) dil2_issue(r, dn, tid, wave, lane);
        sb_compute2(ring, d, qf, y, wave, lane);
        __syncthreads();
        if (!more) break;
        P = Pn; e = en; d = dn;
    }
}
}
#include <hip/hip_bf16.h>
#include <cmath>
constexpr int DM = 1024, NBATCH = 16, SEQ = 2048, MTOK = NBATCH * SEQ, NHEAD = 16, FF = 3584, NEXP = 8;
constexpr int NQKV_D = 9216, NQKV_S = 3072, NGU = 2 * FF;
constexpr int MP_MAX = 2 * MTOK + NEXP * 256;
constexpr float RMS_EPS = 1e-6f;
constexpr int NWAVES = 8;
constexpr size_t MiB = 1u << 20;
constexpr size_t WS_CTL = 0, WS_CMAX = 1 * MiB, CTL_ZERO_BYTES = 64 * 1024;
constexpr size_t WS_RE = 2 * MiB, WS_RW1 = WS_RE + 128 * 1024, WS_RW2 = WS_RW1 + 128 * 1024, WS_POS1 = WS_RW2 + 128 * 1024, WS_POS2 = WS_POS1 + 128 * 1024,
                 WS_GATE = WS_POS2 + 128 * 1024  , WS_CNT = WS_GATE + 512 * 1024  , WS_PTAB = WS_CNT + 16 * 1024  ,
                 WS_SAHN = WS_PTAB + 16 * 1024  , WS_SAY = WS_SAHN + 128 * 1024  , WS_SAHNS = WS_SAY + 128 * 1024  ;
static_assert(WS_SAHNS + 512 * 1024 <= 6 * MiB, "routing / scale arrays");
constexpr size_t WS_W = 6 * MiB;
constexpr size_t W8_IN = 0, W8_OUT = W8_IN + (size_t)2 * NQKV_D * DM, W8_SQKV = W8_OUT + (size_t)2 * DM * DM, W8_FGU = W8_SQKV + (size_t)2 * NQKV_S * DM, W8_MGU = W8_FGU + (size_t)2 * NGU * DM,
                 W_SOUT = W8_MGU + (size_t)16 * NGU * DM, W_FDN = W_SOUT + (size_t)2 * DM * DM * 2, W_MDN = W_FDN + (size_t)2 * DM * FF * 2, W_END = W_MDN + (size_t)16 * DM * FF * 2;
static_assert(W_END == 295698432, "weight bytes");
constexpr int C_IN = 0, C_OUT = C_IN + 2 * NQKV_D, C_SQKV = C_OUT + 2 * DM, C_FGU = C_SQKV + 2 * NQKV_S, C_MGU = C_FGU + 2 * NGU, C_END = C_MGU + 16 * NGU;
static_assert((size_t)C_END * 4 <= 1 * MiB, "absmax words");
constexpr size_t WS_H = 288 * MiB, WS_HN8 = 416 * MiB, WS_Y = 448 * MiB, WS_BIG = 512 * MiB, WS_S = 1088 * MiB, WS_END = 1352 * MiB;
static_assert(WS_W + W_END <= WS_H, "weights fit");
constexpr size_t S_OG = 0, S_LSE = 192 * MiB, S_OSC = 200 * MiB, S_HNS = 0, S_YS = 66 * MiB;
static_assert((size_t)MP_MAX * DM == 66 * MiB && (size_t)MTOK * NQKV_D * 2 == 576 * MiB && (size_t)MP_MAX * FF * 2 <= 576 * MiB && S_YS + (size_t)MP_MAX * DM * 2 <= 264 * MiB, "buffer sizes");
constexpr int CW_TMO = 0, CW_BAR = 4096;
static_assert((size_t)(CW_BAR + 3456) * 4 <= CTL_ZERO_BYTES, "the grid barrier's words lie inside the per-call memset");
constexpr float QMAX = 127.0f, INV_Q2 = 1.0f / (127.0f * 127.0f);

constexpr int RING_OFF = 0, RING_BYTES = 131072;
constexpr int LDSCTL_OFF = RING_BYTES, MISC_OFF = LDSCTL_OFF + 320;
constexpr int LDS_BYTES = 147456;
static_assert(MISC_OFF + 128 <= LDS_BYTES, "LDS map");
#define GAS __attribute__((address_space(1)))
#define LAS __attribute__((address_space(3)))
typedef unsigned short bf16;
typedef unsigned v4u __attribute__((ext_vector_type(4)));
typedef float f32x4 __attribute__((ext_vector_type(4)));
typedef short bf16x8 __attribute__((ext_vector_type(8)));
typedef GAS unsigned gu32;
typedef GAS unsigned long long gu64;
#define RLX_AGENT __ATOMIC_RELAXED, __HIP_MEMORY_SCOPE_AGENT
#define LDS_WAIT() asm volatile("s_waitcnt lgkmcnt(0)" ::: "memory")
#define VM_WAIT() asm volatile("s_waitcnt vmcnt(0)" ::: "memory")
__device__ __forceinline__ unsigned long long rt() { return __builtin_amdgcn_s_memrealtime(); }
__device__ __forceinline__ unsigned f2bf(float f) { unsigned u = __builtin_bit_cast(unsigned, f); return (u + 0x7fffu + ((u >> 16) & 1u)) >> 16; }
__device__ __forceinline__ unsigned pk2(float lo, float hi) { return f2bf(lo) | (f2bf(hi) << 16); }

#define XB_TMO      128
#define XB_XCNT(j)  (256  + 64 * (j))
#define XB_XSUB(j)  (1280 + 64 * (j))
#define XB_XGEN(j)  (2304 + 64 * (j))
#define XB_TOP      3328
#define XB_TOPGEN   3392
#define XCD_BAR_WORDS 3456
#define XB_SPIN_CAP (1u << 18)

__device__ __forceinline__ unsigned xb_ld(unsigned* p)              { return __hip_atomic_load(p, __ATOMIC_RELAXED, __HIP_MEMORY_SCOPE_AGENT); }
__device__ __forceinline__ unsigned xb_add(unsigned* p, unsigned v) { return __hip_atomic_fetch_add(p, v, __ATOMIC_RELAXED, __HIP_MEMORY_SCOPE_AGENT); }
__device__ __forceinline__ unsigned xb_xcc_id() { return (unsigned)__builtin_amdgcn_s_getreg((3 << 11) | 20) & 0xFu; }
#define XB_SPIN(cond, bar) do { unsigned _sp = 0; while (cond) { __builtin_amdgcn_s_sleep(1); \
    if ((++_sp & 255u) == 0u) { if (xb_ld(&(bar)[XB_TMO])) break; if (_sp > XB_SPIN_CAP) { atomicAdd(&(bar)[XB_TMO], 1u); break; } } } } while (0)

struct XcdBarrier {
    unsigned* bar; unsigned x; int t0, wave_s;
    volatile LAS unsigned* st;
};

__device__ __forceinline__ XcdBarrier xcd_barrier_post(unsigned* bar, volatile LAS unsigned* st, int t0) {
    XcdBarrier b; b.bar = bar; b.x = xb_xcc_id(); b.st = st; b.t0 = t0; b.wave_s = 0;
    if (t0) (void)xb_add(&bar[XB_XCNT(b.x)], 1u);
    return b;
}
__device__ __forceinline__ void xcd_barrier_complete(unsigned* bar, unsigned x, unsigned& nloc, unsigned& nx) {
    const unsigned G = gridDim.x * gridDim.y * gridDim.z;
    unsigned sum, cnt, mine, sp = 0u;
    for (;;) {
        sum = 0u; cnt = 0u; mine = 0u;
#pragma unroll
        for (unsigned j = 0; j < 16; ++j) { const unsigned c = xb_ld(&bar[XB_XCNT(j)]); sum += c; cnt += (c > 0u) ? 1u : 0u; mine = (j == x) ? c : mine; }
        if (sum == G) break;
        __builtin_amdgcn_s_sleep(1);
        if ((++sp & 255u) == 0u) { if (xb_ld(&bar[XB_TMO])) break; if (sp > XB_SPIN_CAP) { atomicAdd(&bar[XB_TMO], 1u); break; } }
    }
    nloc = mine > 0u ? mine : 1u; nx = cnt > 0u ? cnt : 1u;
}

__device__ __forceinline__ void xcd_barrier(const XcdBarrier& b) {
    asm volatile("s_waitcnt vmcnt(0)" ::: "memory");
    __syncthreads();
    if (b.wave_s == 0 && lane_id_v() == 0) {
        unsigned* bar = b.bar;
        __builtin_amdgcn_s_waitcnt(0);
        unsigned nloc = b.st[0], nx = b.st[1];
        if (nloc == 0u) { xcd_barrier_complete(bar, b.x, nloc, nx); b.st[0] = nloc; b.st[1] = nx; }
        const unsigned old = xb_add(&bar[XB_XSUB(b.x)], 1u);
        const unsigned gen = old / nloc;
        if (old + 1u == (gen + 1u) * nloc) {
            __builtin_amdgcn_fence(__ATOMIC_RELEASE, "agent");
            asm volatile("s_waitcnt vmcnt(0)" ::: "memory");
            const unsigned og = xb_add(&bar[XB_TOP], 1u);
            const unsigned tg = og / nx;
            if (og + 1u == (tg + 1u) * nx) xb_add(&bar[XB_TOPGEN], 1u);
            else XB_SPIN(xb_ld(&bar[XB_TOPGEN]) == tg, bar);
            __builtin_amdgcn_fence(__ATOMIC_ACQUIRE, "agent");
            xb_add(&bar[XB_XGEN(b.x)], 1u);
            asm volatile("s_waitcnt vmcnt(0)" ::: "memory");
        } else {
            XB_SPIN(xb_ld(&bar[XB_XGEN(b.x)]) == gen, bar);
            __builtin_amdgcn_fence(__ATOMIC_ACQUIRE, "agent");
            asm volatile("s_waitcnt vmcnt(0)" ::: "memory");
        }
    }
    __syncthreads();
}
struct Frame {
    LAS unsigned char* lds;
    volatile LAS unsigned* MISC;
    gu32* ctl;
    int tid, lane, wave;
    int vcu, G, bx;
};
__device__ __forceinline__ unsigned pack_i8x4(float a, float b, float c, float d) {
    const int ia = (int)rintf(a), ib = (int)rintf(b), ic = (int)rintf(c), id = (int)rintf(d);
    return (unsigned)(ia & 0xff) | ((unsigned)(ib & 0xff) << 8) | ((unsigned)(ic & 0xff) << 16) | ((unsigned)(id & 0xff) << 24);
}
template <int BIAS> __device__ __forceinline__ unsigned pack8x4q(float a, float b, float c, float d, float scale) {
    typedef float f2_ __attribute__((ext_vector_type(2)));
    const f2_ s2 = {scale, scale}, m2 = {12582912.0f + (float)BIAS, 12582912.0f + (float)BIAS};
    const f2_ p = __builtin_elementwise_fma((f2_){a, b}, s2, m2), q = __builtin_elementwise_fma((f2_){c, d}, s2, m2);
    return __builtin_amdgcn_perm(__float_as_uint(p.y), __float_as_uint(p.x), 0x0c0c0400u) | __builtin_amdgcn_perm(__float_as_uint(q.y), __float_as_uint(q.x), 0x04000c0cu);
}
__device__ __forceinline__ float bf_lo(unsigned w) { return __uint_as_float(w << 16); }
__device__ __forceinline__ float bf_hi(unsigned w) { return __uint_as_float(w & 0xffff0000u); }

__device__ __forceinline__ void transpose_item(const float* W, int K, int N, bf16* WT, int mode, LAS float* scr, int item, int lane) {
    const int nblk = N / 32, kb = item / nblk, nb = item % nblk, k0 = 64 * kb, n0 = 32 * nb;
    int drow0 = n0;
    if (mode == 1) { const int up = (n0 >= FF) ? 1 : 0, c = n0 - up * FF; drow0 = (c >> 7) * 256 + up * 128 + (c & 127); }
#pragma unroll 8
    for (int i = 0; i < 32; ++i) { const int kk = 2 * i + (lane >> 5); scr[kk * 33 + (lane & 31)] = __builtin_nontemporal_load(W + (size_t)(k0 + kk) * N + n0 + (lane & 31)); }
    LDS_WAIT(); asm volatile("" ::: "memory");
    const int c = lane & 7;
#pragma unroll
    for (int j = 0; j < 4; ++j) { const int n = (lane >> 3) + 8 * j; const LAS float* s = scr + (8 * c) * 33 + n;
        v4u o; o.x = pk2(s[0 * 33], s[1 * 33]); o.y = pk2(s[2 * 33], s[3 * 33]); o.z = pk2(s[4 * 33], s[5 * 33]); o.w = pk2(s[6 * 33], s[7 * 33]);
        *(GAS v4u*)(WT + (size_t)(drow0 + n) * K + k0 + 8 * c) = o; }
    LDS_WAIT(); asm volatile("" ::: "memory");
}
__device__ __forceinline__ void conv_family(Frame& F, const float* src, bf16* dst, int nmat, int K, int N, int mode, LAS float* scr) {
    const int gw = F.vcu * NWAVES + F.wave, NGW = F.G * NWAVES;
    const int ipm = (K / 64) * (N / 32), total = nmat * ipm;
    for (int it = gw; it < total; it += NGW) { const int mat = it / ipm, r = it - mat * ipm;
        transpose_item(src + (size_t)mat * K * N, K, N, dst + (size_t)mat * K * N, mode, scr, r, F.lane); }
}

__device__ __forceinline__ int dest_row(int n, int mode) { if (mode & 1) { const int up = (n >= FF) ? 1 : 0, c = n - up * FF; return (c >> 7) * 256 + up * 128 + (c & 127); } return n; }
__device__ __forceinline__ void absmax_family(Frame& F, const float* src, unsigned* cmax, int nmat, int K, int N, int mode) {
    const int gw = F.vcu * NWAVES + F.wave, NGW = F.G * NWAVES;
    const int nch = N / 256, ipm = (K / 64) * nch, total = nmat * ipm;
    for (int it = gw; it < total; it += NGW) { const int mat = it / ipm, r = it - mat * ipm, kc = r / nch, nc = r - kc * nch;
        const float* W = src + (size_t)mat * K * N + (size_t)(kc * 64) * N + nc * 256 + 4 * F.lane;
        f32x4 mx = {0.f, 0.f, 0.f, 0.f};
#pragma unroll 8
        for (int k = 0; k < 64; ++k) { const f32x4 w = *(const f32x4*)(W + (size_t)k * N); mx.x = fmaxf(mx.x, fabsf(w.x)); mx.y = fmaxf(mx.y, fabsf(w.y)); mx.z = fmaxf(mx.z, fabsf(w.z)); mx.w = fmaxf(mx.w, fabsf(w.w)); }
        unsigned* c = cmax + (size_t)mat * N + dest_row(nc * 256 + 4 * F.lane, mode);
        atomicMax(c + 0, __float_as_uint(mx.x)); atomicMax(c + 1, __float_as_uint(mx.y)); atomicMax(c + 2, __float_as_uint(mx.z)); atomicMax(c + 3, __float_as_uint(mx.w));
    }
}
__device__ __forceinline__ void quant_item(const float* W, int K, int N, unsigned char* WT, const unsigned* cmax, int mode, LAS float* scr, int item, int lane) {
    const int nblk = N / 32, kb = item / nblk, nb = item % nblk, k0 = 64 * kb, n0 = 32 * nb;
    const int drow0 = dest_row(n0, mode);
#pragma unroll 8
    for (int i = 0; i < 32; ++i) { const int kk = 2 * i + (lane >> 5); scr[kk * 33 + (lane & 31)] = W[(size_t)(k0 + kk) * N + n0 + (lane & 31)]; }
    LDS_WAIT(); asm volatile("" ::: "memory");
    const int c = lane & 7;
#pragma unroll
    for (int j = 0; j < 4; ++j) { const int n = (lane >> 3) + 8 * j; const LAS float* s = scr + (8 * c) * 33 + n;
        const float am = __uint_as_float(cmax[drow0 + n]), inv = am > 0.f ? QMAX / am : 0.f;
        const unsigned lo = pack8x4q<0>(s[0 * 33], s[1 * 33], s[2 * 33], s[3 * 33], inv), hi = pack8x4q<0>(s[4 * 33], s[5 * 33], s[6 * 33], s[7 * 33], inv);
        *(GAS unsigned long long*)(WT + (size_t)(drow0 + n) * K + k0 + 8 * c) = (unsigned long long)lo | ((unsigned long long)hi << 32); }
    LDS_WAIT(); asm volatile("" ::: "memory");
}
__device__ __forceinline__ void quant_family(Frame& F, const float* src, unsigned char* dst, const unsigned* cmax, int nmat, int K, int N, int mode, LAS float* scr) {
    const int gw = F.vcu * NWAVES + F.wave, NGW = F.G * NWAVES;
    const int ipm = (K / 64) * (N / 32), total = nmat * ipm;
    for (int it = gw; it < total; it += NGW) { const int mat = it / ipm, r = it - mat * ipm;
        quant_item(src + (size_t)mat * K * N, K, N, dst + (size_t)mat * K * N, cmax + (size_t)mat * N, mode, scr, r, F.lane); }
}

__device__ __forceinline__ void quant_strips(Frame& F, const float* src, unsigned char* dst, float* cmax, int nmat, int N, int mode) {
    constexpr int K = 1024;
    LAS float* T = (LAS float*)(F.lds + RING_OFF);
    LAS float* P = (LAS float*)(F.lds + LDSCTL_OFF + 1024);
    const int spm = N / 32, total = nmat * spm;
    const int n = F.tid & 31, kg = F.tid >> 5;
    for (int it = F.vcu; it < total; it += F.G) {
        const int mat = it / spm, n0 = 32 * (it - mat * spm);
        const float* W = src + (size_t)mat * K * N + n0 + (F.lane & 7) * 4;
#pragma unroll
        for (int j = 0; j < 16; ++j) { const int q = j * 8 + F.wave;
            __builtin_amdgcn_global_load_lds((const unsigned*)(W + (size_t)(8 * q + (F.lane >> 3)) * N), (LAS unsigned*)((LAS unsigned char*)T + q * 1024), 16, 0, 2); }
        asm volatile("s_waitcnt vmcnt(0)" ::: "memory");
        __syncthreads();
        float v[64]; float am = 0.f;
#pragma unroll
        for (int i = 0; i < 64; ++i) { v[i] = T[(kg * 64 + i) * 32 + n]; am = fmaxf(am, fabsf(v[i])); }
        P[kg * 32 + n] = am;
        __syncthreads();
        float cm = 0.f;
#pragma unroll
        for (int g = 0; g < 16; ++g) cm = fmaxf(cm, P[g * 32 + n]);
        const float inv = cm > 0.f ? QMAX / cm : 0.f;
        const int drow = dest_row(n0, mode) + n;
        unsigned char* o = dst + (size_t)mat * K * N + (size_t)drow * K + kg * 64;
#pragma unroll
        for (int c = 0; c < 4; ++c) { v4u w;
            w.x = pack8x4q<0>(v[16 * c + 0], v[16 * c + 1], v[16 * c + 2], v[16 * c + 3], inv); w.y = pack8x4q<0>(v[16 * c + 4], v[16 * c + 5], v[16 * c + 6], v[16 * c + 7], inv);
            w.z = pack8x4q<0>(v[16 * c + 8], v[16 * c + 9], v[16 * c + 10], v[16 * c + 11], inv); w.w = pack8x4q<0>(v[16 * c + 12], v[16 * c + 13], v[16 * c + 14], v[16 * c + 15], inv);
            *(GAS v4u*)(o + 16 * c) = w; }
        if (kg == 0) cmax[(size_t)mat * N + drow] = cm;
        __syncthreads();
    }
}

__device__ __forceinline__ void ld8_bf16(float (&v)[8], const bf16* p) { const v4u w = *(const v4u*)p;
#pragma unroll
    for (int k = 0; k < 4; ++k) { v[2 * k] = bf_lo(w[k]); v[2 * k + 1] = bf_hi(w[k]); } }
__device__ __forceinline__ void ld8_f32(float (&v)[8], const float* p) { const f32x4 a = *(const f32x4*)p, b = *(const f32x4*)(p + 4); v[0] = a.x; v[1] = a.y; v[2] = a.z; v[3] = a.w; v[4] = b.x; v[5] = b.y; v[6] = b.z; v[7] = b.w; }
__device__ __forceinline__ void st8_bf16(bf16* p, const float (&v)[8]) { v4u w; w.x = pk2(v[0], v[1]); w.y = pk2(v[2], v[3]); w.z = pk2(v[4], v[5]); w.w = pk2(v[6], v[7]); *(v4u*)p = w; }
template <int MODE>
__device__ __forceinline__ void norm_load(Frame& F, int m, float (&v)[2][8], const float* x, const bf16* h, const bf16* ys, const int* pos1, const int* pos2) {
#pragma unroll
    for (int j = 0; j < 2; ++j) { if (MODE == 0) ld8_f32(v[j], x + (size_t)m * DM + 512 * j + 8 * F.lane); else ld8_bf16(v[j], h + (size_t)m * DM + 512 * j + 8 * F.lane); }
    if (MODE == 2 || MODE == 3) {
        const int p1 = __hip_atomic_load(pos1 + m, __ATOMIC_RELAXED, __HIP_MEMORY_SCOPE_AGENT), p2 = __hip_atomic_load(pos2 + m, __ATOMIC_RELAXED, __HIP_MEMORY_SCOPE_AGENT);
#pragma unroll
        for (int j = 0; j < 2; ++j) { float a[8], b[8]; ld8_bf16(a, ys + (size_t)p1 * DM + 512 * j + 8 * F.lane); ld8_bf16(b, ys + (size_t)p2 * DM + 512 * j + 8 * F.lane);
#pragma unroll
            for (int k = 0; k < 8; ++k) v[j][k] += a[k] + b[k]; }
    }
}
template <int MODE>
__device__ __forceinline__ void norm_finish(Frame& F, int m, float (&v)[2][8], const float (&gn)[2][8], bf16* h, unsigned char* hn8, float* sa, float* out) {
    if (MODE == 0 || MODE == 2) {
#pragma unroll
        for (int j = 0; j < 2; ++j) st8_bf16(h + (size_t)m * DM + 512 * j + 8 * F.lane, v[j]); }
    float s2 = 0.f;
#pragma unroll
    for (int j = 0; j < 2; ++j)
#pragma unroll
        for (int k = 0; k < 8; ++k) s2 += v[j][k] * v[j][k];
    const float rstd = __builtin_amdgcn_rsqf(wave_sum(s2) * (1.f / DM) + RMS_EPS);
    if (MODE == 3) {
#pragma unroll
        for (int j = 0; j < 2; ++j) { f32x4* o = (f32x4*)(out + (size_t)m * DM + 512 * j + 8 * F.lane);
            o[0] = (f32x4){v[j][0] * rstd * gn[j][0], v[j][1] * rstd * gn[j][1], v[j][2] * rstd * gn[j][2], v[j][3] * rstd * gn[j][3]};
            o[1] = (f32x4){v[j][4] * rstd * gn[j][4], v[j][5] * rstd * gn[j][5], v[j][6] * rstd * gn[j][6], v[j][7] * rstd * gn[j][7]}; }
    } else {
        float am = 0.f;
#pragma unroll
        for (int j = 0; j < 2; ++j)
#pragma unroll
            for (int k = 0; k < 8; ++k) { v[j][k] = v[j][k] * rstd * gn[j][k]; am = fmaxf(am, fabsf(v[j][k])); }
        am = wave_max(am); const float inv = am > 0.f ? QMAX * __builtin_amdgcn_rcpf(am) : 0.f;
#pragma unroll
        for (int j = 0; j < 2; ++j) { const unsigned lo = pack8x4q<0>(v[j][0], v[j][1], v[j][2], v[j][3], inv), hi = pack8x4q<0>(v[j][4], v[j][5], v[j][6], v[j][7], inv);
            *(unsigned long long*)(hn8 + (size_t)m * DM + 512 * j + 8 * F.lane) = (unsigned long long)lo | ((unsigned long long)hi << 32); }
        if (F.lane == 0) sa[m] = am * INV_Q2; }
}
template <int MODE>
__device__ __forceinline__ void norm_rows(Frame& F, const float* x, bf16* h, unsigned char* hn8, float* sa, float* out, const float* gain, const bf16* ys, const int* pos1, const int* pos2) {
    const int gw = F.vcu * NWAVES + F.wave, NGW = F.G * NWAVES;
    float gn[2][8];
#pragma unroll
    for (int j = 0; j < 2; ++j) ld8_f32(gn[j], gain + 512 * j + 8 * F.lane);
    for (int m = gw; m < MTOK; m += 2 * NGW) {
        const int m1 = m + NGW; const bool two = m1 < MTOK;
        float va[2][8], vb[2][8];
        norm_load<MODE>(F, m, va, x, h, ys, pos1, pos2);
        norm_load<MODE>(F, two ? m1 : m, vb, x, h, ys, pos1, pos2);
        norm_finish<MODE>(F, m, va, gn, h, hn8, sa, out);
        if (two) norm_finish<MODE>(F, m1, vb, gn, h, hn8, sa, out);
    }
}

__device__ __forceinline__ void unpack8(float (&v)[8], const v4u w) {
#pragma unroll
    for (int k = 0; k < 4; ++k) { v[2 * k] = bf_lo(w[k]); v[2 * k + 1] = bf_hi(w[k]); } }
__device__ __forceinline__ float reduce8_butterfly(const float (&v)[8], int lane) {
    float w[4], x[2];
#pragma unroll
    for (int e = 0; e < 4; ++e) { auto r = __builtin_amdgcn_permlane32_swap(__float_as_uint(v[e]), __float_as_uint(v[e + 4]), false, false); w[e] = __uint_as_float(r[0]) + __uint_as_float(r[1]); }
#pragma unroll
    for (int e = 0; e < 2; ++e) { auto r = __builtin_amdgcn_permlane16_swap(__float_as_uint(w[e]), __float_as_uint(w[e + 2]), false, false); x[e] = __uint_as_float(r[0]) + __uint_as_float(r[1]); }
    const bool hi8 = (lane & 8) != 0;
    const float keep = hi8 ? x[1] : x[0], send = hi8 ? x[0] : x[1];
    float y = keep + dppf<0x128>(send);
    y += dppf<0xB1>(y); y += dppf<0x4E>(y); y += dppf<0x141>(y);
    return y;
}
__device__ __forceinline__ int router_pair(Frame& F, int m, int i, float (&va)[2][8], float (&vb)[2][8], const float (&gn)[2][8], unsigned char* hn8, const LAS f32x4* wl, float& ksa, int& kre, float& kw1, float& kw2) {
    float s2a = 0.f, s2b = 0.f;
#pragma unroll
    for (int j = 0; j < 2; ++j)
#pragma unroll
        for (int k = 0; k < 8; ++k) { s2a += va[j][k] * va[j][k]; s2b += vb[j][k] * vb[j][k]; }
    const float rstda = __builtin_amdgcn_rsqf(wave_sum(s2a) * (1.f / DM) + RMS_EPS), rstdb = __builtin_amdgcn_rsqf(wave_sum(s2b) * (1.f / DM) + RMS_EPS);
    float ama = 0.f, amb = 0.f;
#pragma unroll
    for (int j = 0; j < 2; ++j)
#pragma unroll
        for (int k = 0; k < 8; ++k) { va[j][k] = va[j][k] * rstda * gn[j][k]; ama = fmaxf(ama, fabsf(va[j][k])); vb[j][k] = vb[j][k] * rstdb * gn[j][k]; amb = fmaxf(amb, fabsf(vb[j][k])); }
    ama = wave_max(ama); amb = wave_max(amb);
    const float inva = ama > 0.f ? QMAX * __builtin_amdgcn_rcpf(ama) : 0.f, invb = amb > 0.f ? QMAX * __builtin_amdgcn_rcpf(amb) : 0.f;
    ksa = (F.lane == i) ? ama * INV_Q2 : ((F.lane == i + 1) ? amb * INV_Q2 : ksa);
    typedef float f2_ __attribute__((ext_vector_type(2)));
    f2_ la2[4] = {{0.f, 0.f}, {0.f, 0.f}, {0.f, 0.f}, {0.f, 0.f}}, lb2[4] = {{0.f, 0.f}, {0.f, 0.f}, {0.f, 0.f}, {0.f, 0.f}};
#pragma unroll
    for (int j = 0; j < 2; ++j) {
        { const unsigned lo = pack8x4q<0>(va[j][0], va[j][1], va[j][2], va[j][3], inva), hi = pack8x4q<0>(va[j][4], va[j][5], va[j][6], va[j][7], inva);
          *(unsigned long long*)(hn8 + (size_t)m * DM + 512 * j + 8 * F.lane) = (unsigned long long)lo | ((unsigned long long)hi << 32); }
        { const unsigned lo = pack8x4q<0>(vb[j][0], vb[j][1], vb[j][2], vb[j][3], invb), hi = pack8x4q<0>(vb[j][4], vb[j][5], vb[j][6], vb[j][7], invb);
          *(unsigned long long*)(hn8 + (size_t)(m + 1) * DM + 512 * j + 8 * F.lane) = (unsigned long long)lo | ((unsigned long long)hi << 32); }
        f32x4 wq[8][2];
#pragma unroll
        for (int q = 0; q < 8; ++q) { wq[q][0] = wl[(j * 8 + q) * 64 + F.lane]; wq[q][1] = wl[(16 + j * 8 + q) * 64 + F.lane]; }
#pragma unroll
        for (int q = 0; q < 8; ++q) { const f32x4 wa = wq[q][0], wb = wq[q][1]; const f2_ ta = {va[j][q], va[j][q]}, tb = {vb[j][q], vb[j][q]};
            const f2_ w01 = {wa.x, wa.y}, w23 = {wa.z, wa.w}, w45 = {wb.x, wb.y}, w67 = {wb.z, wb.w};
            la2[0] = __builtin_elementwise_fma(ta, w01, la2[0]); la2[1] = __builtin_elementwise_fma(ta, w23, la2[1]); la2[2] = __builtin_elementwise_fma(ta, w45, la2[2]); la2[3] = __builtin_elementwise_fma(ta, w67, la2[3]);
            lb2[0] = __builtin_elementwise_fma(tb, w01, lb2[0]); lb2[1] = __builtin_elementwise_fma(tb, w23, lb2[1]); lb2[2] = __builtin_elementwise_fma(tb, w45, lb2[2]); lb2[3] = __builtin_elementwise_fma(tb, w67, lb2[3]); } }
    float la[8], lb[8];
#pragma unroll
    for (int e = 0; e < 4; ++e) { la[2 * e] = la2[e].x; la[2 * e + 1] = la2[e].y; lb[2 * e] = lb2[e].x; lb[2 * e + 1] = lb2[e].y; }
#pragma unroll
    for (int e = 0; e < 8; ++e) { (void)e; }
    { const float ya = reduce8_butterfly(la, F.lane), yb = reduce8_butterfly(lb, F.lane);
#pragma unroll
      for (int e = 0; e < 8; ++e) { la[e] = __int_as_float(__builtin_amdgcn_readlane(__float_as_int(ya), 16 * (e >> 1) + 8 * (e & 1))); lb[e] = __int_as_float(__builtin_amdgcn_readlane(__float_as_int(yb), 16 * (e >> 1) + 8 * (e & 1))); } }
    int res = 0;
#pragma unroll
    for (int r = 0; r < 2; ++r) { const float (&lg)[8] = r ? lb : la;
        int e1 = 0; float v1 = lg[0];
#pragma unroll
        for (int e = 1; e < 8; ++e) if (lg[e] > v1) { v1 = lg[e]; e1 = e; }
        int e2 = -1; float v2 = -INFINITY;
#pragma unroll
        for (int e = 0; e < 8; ++e) if (e != e1 && lg[e] > v2) { v2 = lg[e]; e2 = e; }
        const float w1 = __builtin_amdgcn_rcpf(1.0f + __expf(v2 - v1)), w2 = 1.0f - w1;
        if (F.lane == i + r) { kre = e1 | (e2 << 8); kw1 = w1; kw2 = w2; }
        res |= (e1 | (e2 << 8)) << (16 * r); }
    return res;
}
__device__ __forceinline__ void router_part1(Frame& F, const bf16* h, unsigned char* hn8, float* sa, const float* gain, const float* wr  , int* re, float* rw1, float* rw2, int* cnt_g) {
    LAS int* wc = (LAS int*)(F.lds + RING_OFF);
    LAS f32x4* wl = (LAS f32x4*)(F.lds + RING_OFF + 1024);
    for (int c = F.tid; c < 2048; c += NWAVES * 64) { const int k = c >> 1, hf = c & 1; wl[(hf * 16 + (k >> 9) * 8 + (k & 7)) * 64 + ((k >> 3) & 63)] = ((const f32x4*)wr)[c]; }
    float gn[2][8];
#pragma unroll
    for (int j = 0; j < 2; ++j) ld8_f32(gn[j], gain + 512 * j + 8 * F.lane);
    __syncthreads();
    for (int tb = F.bx; tb < MTOK / 128; tb += F.G) {
        int c0 = 0, c1 = 0, c2 = 0, c3 = 0, c4 = 0, c5 = 0, c6 = 0, c7 = 0;
        const int mbase = tb * 128 + F.wave * 16;
        float ksa = 0.f, kw1 = 0.f, kw2 = 0.f; int kre = 0;
        v4u ra[2], rb[2];
#pragma unroll
        for (int j = 0; j < 2; ++j) { ra[j] = *(const v4u*)(h + (size_t)mbase * DM + 512 * j + 8 * F.lane); rb[j] = *(const v4u*)(h + (size_t)(mbase + 1) * DM + 512 * j + 8 * F.lane); }
        for (int i = 0; i < 16; i += 2) {
            const int m = mbase + i, mn = mbase + ((i + 2 < 16) ? i + 2 : i);
            v4u na[2], nb[2];
#pragma unroll
            for (int j = 0; j < 2; ++j) { na[j] = *(const v4u*)(h + (size_t)mn * DM + 512 * j + 8 * F.lane); nb[j] = *(const v4u*)(h + (size_t)(mn + 1) * DM + 512 * j + 8 * F.lane); }
            __builtin_amdgcn_sched_barrier(0);
            float va[2][8], vb[2][8];
#pragma unroll
            for (int j = 0; j < 2; ++j) { unpack8(va[j], ra[j]); unpack8(vb[j], rb[j]); }
            const int ee2 = router_pair(F, m, i, va, vb, gn, hn8, wl, ksa, kre, kw1, kw2);
#pragma unroll
            for (int t = 0; t < 2; ++t) { const int ee = (ee2 >> (16 * t)) & 0xffff, e1 = ee & 0xff, e2 = ee >> 8;
                c0 += (e1 == 0) + (e2 == 0); c1 += (e1 == 1) + (e2 == 1); c2 += (e1 == 2) + (e2 == 2); c3 += (e1 == 3) + (e2 == 3);
                c4 += (e1 == 4) + (e2 == 4); c5 += (e1 == 5) + (e2 == 5); c6 += (e1 == 6) + (e2 == 6); c7 += (e1 == 7) + (e2 == 7); }
#pragma unroll
            for (int j = 0; j < 2; ++j) { ra[j] = na[j]; rb[j] = nb[j]; }
        }
        if (F.lane < 16) { sa[mbase + F.lane] = ksa; re[mbase + F.lane] = kre; rw1[mbase + F.lane] = kw1; rw2[mbase + F.lane] = kw2; }
        if (F.lane == 0) { LAS int* w = wc + F.wave * 8; w[0] = c0; w[1] = c1; w[2] = c2; w[3] = c3; w[4] = c4; w[5] = c5; w[6] = c6; w[7] = c7; }
        __syncthreads();
        if (F.tid < 8) { int s = 0;
#pragma unroll
            for (int w = 0; w < 8; ++w) s += wc[w * 8 + F.tid];
            cnt_g[tb * 8 + F.tid] = s; }
        __syncthreads();
    }
}
__device__ __forceinline__ void router_part2(Frame& F, const unsigned char* hn8, const float* sa, unsigned char* hns8, float* sas, const int* re, const float* rw1, const float* rw2, const int* cnt_g, int* pos1, int* pos2, float* gate, unsigned* ptab) {
    LAS int* cg = (LAS int*)(F.lds + RING_OFF);
    LAS int* tot = cg + 2048; LAS int* pre = cg + 2056; LAS int* wcnt = cg + 2064;
    for (int tb = F.bx; tb < MTOK / 128; tb += F.G) {
        for (int k = F.tid; k < 2048; k += NWAVES * 64) cg[k] = cnt_g[k];
        __syncthreads();
        { const int e = F.wave; int t = 0, p = 0;
#pragma unroll
          for (int q = 0; q < 4; ++q) { const int c = F.lane * 4 + q; const int v = cg[c * 8 + e]; t += v; p += (c < tb) ? v : 0; }
          t = wave_sum_i(t); p = wave_sum_i(p);
          if (F.lane == 0) { tot[e] = t; pre[e] = p; } }
        const bool act = F.lane < 16;
        const int m = tb * 128 + F.wave * 16 + (F.lane & 15);
        const int ee = re[m], e1 = ee & 0xff, e2 = (ee >> 8) & 0xff;
        unsigned long long mk[8];
#pragma unroll
        for (int e = 0; e < 8; ++e) { mk[e] = __ballot(act && (e1 == e || e2 == e)); if (F.lane == e) wcnt[F.wave * 8 + e] = __popcll(mk[e]); }
        __syncthreads();
        int seg = 0, p1 = 0, p2 = 0, mypad0 = 0, mypad1 = 0;
        const unsigned long long lt = (1ull << F.lane) - 1ull;
#pragma unroll
        for (int e = 0; e < 8; ++e) {
            const int te = tot[e]; int bse = seg + pre[e];
            for (int w = 0; w < F.wave; ++w) bse += wcnt[w * 8 + e];
            const int rank = __popcll(mk[e] & lt);
            if (e1 == e) p1 = bse + rank;
            if (e2 == e) p2 = bse + rank;
            const int segn = seg + ((te + 255) & ~255);
            if (tb == e) { mypad0 = seg + te; mypad1 = segn; }
            if (tb == 0) { for (int p = seg / 256 + F.tid; p < segn / 256; p += NWAVES * 64) __hip_atomic_store(ptab + 64 + p, (unsigned)e, __ATOMIC_RELAXED, __HIP_MEMORY_SCOPE_AGENT); }
            if (tb == 0 && F.tid == 0 && e < 7) __hip_atomic_store(ptab + 32 + e, (unsigned)(segn / 256), __ATOMIC_RELAXED, __HIP_MEMORY_SCOPE_AGENT);
            seg = segn;
        }
        if (tb == 0 && F.tid == 0) __hip_atomic_store(ptab, (unsigned)(seg / 256), __ATOMIC_RELAXED, __HIP_MEMORY_SCOPE_AGENT);
        if (act) { pos1[m] = p1; pos2[m] = p2; gate[p1] = rw1[m]; gate[p2] = rw2[m]; const float s = sa[m]; sas[p1] = s; sas[p2] = s; }
        { v4u rowv[16];
#pragma unroll
          for (int i = 0; i < 16; ++i) rowv[i] = *(const GAS v4u*)(hn8 + (size_t)(tb * 128 + F.wave * 16 + i) * DM + F.lane * 16);
#pragma unroll
          for (int i = 0; i < 16; ++i) { const int q1 = __builtin_amdgcn_readlane(p1, i), q2 = __builtin_amdgcn_readlane(p2, i);
              *(GAS v4u*)(hns8 + (size_t)q1 * DM + F.lane * 16) = rowv[i]; *(GAS v4u*)(hns8 + (size_t)q2 * DM + F.lane * 16) = rowv[i]; } }
        if (tb < 8) {
            unsigned zz = 0u; asm volatile("" : "+v"(zz)); const v4u z = {zz, zz, zz, zz};
            for (int r = mypad0 + F.wave; r < mypad1; r += NWAVES) { *(GAS v4u*)(hns8 + (size_t)r * DM + F.lane * 16) = z; if (F.lane == 0) { gate[r] = 0.f; sas[r] = 0.f; } }
        }
        __syncthreads();
    }
}
constexpr int N_PHASES = 35;
#ifndef SKEW_DT
#define SKEW_DT 375u
#endif
#ifndef PG8_ALIGN_EPI
#define PG8_ALIGN_EPI true
#endif
#ifndef PROBE_EPI
#define PROBE_EPI 0
#endif
#ifndef PROBE_DOUBLE
#define PROBE_DOUBLE 0
#endif
struct Args { const float* x; const float* mix_norm; const float* ffn_norm; const float* dil_w_in; const float* dil_w_out; const float* sb_w_qkv; const float* sb_w_out;
              const float* ffn_gu; const float* ffn_dn; const float* moe_router; const float* moe_gu; const float* moe_dn; const float* final_norm; float* out; unsigned char* ws; int lo, hi, li, pad; };
typedef const __attribute__((address_space(4))) Args* KArgs;
__device__ __forceinline__ KArgs kargs() { KArgs p = (KArgs)__builtin_amdgcn_kernarg_segment_ptr(); asm volatile("" : "+s"(p)); return p; }
__device__ __forceinline__ void make_frame(Frame& F, LAS unsigned char* lds, unsigned char* ws, int wave_s) {
    const int t = wave_s * 64 + lane_id_v();
    int bx = blockIdx.x, G = gridDim.x; asm volatile("" : "+s"(bx), "+s"(G));
    F.lds = lds; F.MISC = (volatile LAS unsigned*)(lds + MISC_OFF); F.ctl = (gu32*)(ws + WS_CTL);
    F.tid = t; F.lane = t & 63; F.wave = wave_s;
    F.G = G; F.vcu = (G % 8 == 0) ? (bx % 8) * (G / 8) + bx / 8 : bx; F.bx = bx;
}
#define WPTR(off) ((bf16*)(ws + WS_W + (off)))
__global__ void __launch_bounds__(NWAVES * 64, 2) mk_fwd(Args a_) {
    extern __shared__ __attribute__((aligned(16))) unsigned char lds_[];
    LAS unsigned char* const lds = (LAS unsigned char*)lds_;
    for (int u = threadIdx.x; u < (LDS_BYTES - LDSCTL_OFF) / 4; u += NWAVES * 64) ((LAS unsigned*)(lds + LDSCTL_OFF))[u] = 0u;
    const int wave_s = __builtin_amdgcn_readfirstlane(threadIdx.x >> 6);
    const int t0_ = (threadIdx.x == 0);
    __syncthreads();
    int lo, hi;
    XcdBarrier bar;
    { KArgs ka = kargs(); lo = ka->lo; hi = ka->hi; unsigned* bw = (unsigned*)(ka->ws + WS_CTL) + CW_BAR + ka->li * XCD_BAR_WORDS;
      bar.bar = bw; bar.x = 0; bar.st = nullptr; bar.t0 = 0; bar.wave_s = wave_s;
      if (hi - lo > 1) { bar = xcd_barrier_post(bw, (volatile LAS unsigned*)(lds + MISC_OFF) + 8, t0_); bar.wave_s = wave_s; } }
#define IN(k) (lo <= (k) && (k) < hi)
#ifndef PROBE_BAR
#define PROBE_BAR 0
#endif
#define SEAM(k) do { if (IN(k) && IN((k) + 1)) { xcd_barrier(bar); if (PROBE_BAR) xcd_barrier(bar); } } while (0)
#define CTX() KArgs ka = kargs(); unsigned char* const ws = ka->ws; Frame F; make_frame(F, lds, ws, wave_s); LAS unsigned char* const ring = lds + RING_OFF; (void)ring

    for (int rep_ = 0; rep_ < ((PROBE_DOUBLE & 1) ? 2 : 1); ++rep_)
    if (IN(0)) { CTX();
        float* cm = (float*)(ws + WS_CMAX); unsigned char* w8 = ws + WS_W;
        quant_strips(F, ka->moe_gu,    w8 + W8_MGU,  cm + C_MGU, 16, NGU,    1);
        quant_strips(F, ka->dil_w_in,  w8 + W8_IN,   cm + C_IN,   2, NQKV_D, 0);
        quant_strips(F, ka->ffn_gu,    w8 + W8_FGU,  cm + C_FGU,  2, NGU,    1);
        quant_strips(F, ka->sb_w_qkv,  w8 + W8_SQKV, cm + C_SQKV, 2, NQKV_S, 0);
        quant_strips(F, ka->dil_w_out, w8 + W8_OUT,  cm + C_OUT,  2, DM,     0);
        LAS float* scr = (LAS float*)(ring + F.wave * 16384);
        conv_family(F, ka->moe_dn,    WPTR(W_MDN), 16, FF, DM, 0, scr);
        conv_family(F, ka->ffn_dn,    WPTR(W_FDN),  2, FF, DM, 0, scr);
        conv_family(F, ka->sb_w_out,  WPTR(W_SOUT), 2, DM, DM, 0, scr);
        norm_rows<0>(F, ka->x, (bf16*)(ws + WS_H), ws + WS_HN8, (float*)(ws + WS_SAHN), nullptr, ka->mix_norm, nullptr, nullptr, nullptr);
        __syncthreads();
    }
    SEAM(1);

    for (int lp = 0; lp < 2; ++lp) {
        const int pb = 2 + 16 * lp;
        if (IN(pb + 0)) { CTX();
            if (lp != 0) norm_rows<2>(F, nullptr, (bf16*)(ws + WS_H), ws + WS_HN8, (float*)(ws + WS_SAHN), nullptr, ka->mix_norm + (size_t)(2 * lp) * DM, (const bf16*)(ws + WS_S + S_YS), (const int*)(ws + WS_POS1), (const int*)(ws + WS_POS2));
        }
        if (lp != 0) SEAM(pb + 0);
        for (int rep_ = 0; rep_ < ((PROBE_DOUBLE & 64) ? 2 : 1); ++rep_)
        if (IN(pb + 1)) { CTX(); pg8::Gemm g{(const bf16*)(ws + WS_HN8), (const bf16*)(ws + WS_W + W8_IN + (size_t)lp * NQKV_D * DM), MTOK, NQKV_D, DM / 2}; pg8::StaticOrderT<NQKV_D / 256> S; S.init(MTOK,  NQKV_D, F.G, F.bx, F.wave); S.probe_same = rep_;
            pg8::EpiStore<true, 2> E{(bf16*)(ws + WS_BIG), NQKV_D, (const float*)(ws + WS_SAHN), (const float*)(ws + WS_CMAX) + C_IN + lp * NQKV_D, 0.125f * 1.4426950408889634f};
            pg8::gemm_phase<pg8::EpiStore<true, 2>, decltype(S), PG8_ALIGN_EPI, true>(ring, g, S, E); }
        SEAM(pb + 1);
        for (int rep_ = 0; rep_ < ((PROBE_DOUBLE & 2) ? 2 : 1); ++rep_)
        if (IN(pb + 2)) { CTX(); att::dilated_phase2((const bf16*)(ws + WS_BIG), ws + WS_S + S_OG, (float*)(ws + WS_S + S_LSE), (float*)(ws + WS_S + S_OSC), ring, F.vcu, F.G, F.tid, F.wave, F.lane); }
        SEAM(pb + 2);
        for (int rep_ = 0; rep_ < ((PROBE_DOUBLE & 4) ? 2 : 1); ++rep_)
        if (IN(pb + 3)) { CTX(); for (int m = F.vcu * NWAVES + F.wave; m < MTOK; m += F.G * NWAVES * 2) att::dilated_combine_2rows(ws + WS_S + S_OG, (const float*)(ws + WS_S + S_LSE), (const float*)(ws + WS_S + S_OSC), ws + WS_Y, (float*)(ws + WS_SAY), m, m + F.G * NWAVES, F.lane); }
        SEAM(pb + 3);
        if (IN(pb + 4)) { CTX(); pg8::Gemm g{(const bf16*)(ws + WS_Y), (const bf16*)(ws + WS_W + W8_OUT + (size_t)lp * DM * DM), MTOK, DM, DM / 2}; pg8::StaticOrderT<DM / 256> S; S.init(MTOK,  DM, F.G, F.bx, F.wave);
            pg8::EpiResid<true> E{(bf16*)(ws + WS_H), DM, (const float*)(ws + WS_SAY), (const float*)(ws + WS_CMAX) + C_OUT + lp * DM};
            pg8::gemm_phase<pg8::EpiResid<true>, decltype(S), PG8_ALIGN_EPI, true>(ring, g, S, E); }
        SEAM(pb + 4);
        for (int rep_ = 0; rep_ < ((PROBE_DOUBLE & 8) ? 2 : 1); ++rep_)
        if (IN(pb + 5)) { CTX(); norm_rows<1>(F, nullptr, (bf16*)(ws + WS_H), ws + WS_HN8, (float*)(ws + WS_SAHN), nullptr, ka->ffn_norm + (size_t)(2 * lp) * DM, nullptr, nullptr, nullptr); }
        SEAM(pb + 5);
        for (int rep_ = 0; rep_ < ((PROBE_DOUBLE & 128) ? 2 : 1); ++rep_)
        if (IN(pb + 6)) { CTX(); pg8::Gemm g{(const bf16*)(ws + WS_HN8), (const bf16*)(ws + WS_W + W8_FGU + (size_t)lp * NGU * DM), MTOK, NGU, DM / 2}; pg8::StaticOrderT<NGU / 256> S; S.init(MTOK,  NGU, F.G, F.bx, F.wave);
            pg8::EpiSwiGLU<true> E{(bf16*)(ws + WS_BIG), FF, (const float*)(ws + WS_SAHN), (const float*)(ws + WS_CMAX) + C_FGU + lp * NGU};
            pg8::gemm_phase<pg8::EpiSwiGLU<true>, decltype(S), PG8_ALIGN_EPI, true>(ring, g, S, E); }
        SEAM(pb + 6);
        if (IN(pb + 7)) { CTX(); pg8::Gemm g{(const bf16*)(ws + WS_BIG), WPTR(W_FDN) + (size_t)lp * DM * FF, MTOK, DM, FF}; pg8::StaticOrderT<DM / 256> S; S.init(MTOK,  DM, F.G, F.bx, F.wave); pg8::EpiResid<false> E{(bf16*)(ws + WS_H), DM, nullptr, nullptr};
            pg8::gemm_phase<pg8::EpiResid<false>, decltype(S), PG8_ALIGN_EPI, true>(ring, g, S, E); }
        SEAM(pb + 7);
        for (int rep_ = 0; rep_ < ((PROBE_DOUBLE & 8) ? 2 : 1); ++rep_)
        if (IN(pb + 8)) { CTX(); norm_rows<1>(F, nullptr, (bf16*)(ws + WS_H), ws + WS_HN8, (float*)(ws + WS_SAHN), nullptr, ka->mix_norm + (size_t)(2 * lp + 1) * DM, nullptr, nullptr, nullptr); }
        SEAM(pb + 8);
        for (int rep_ = 0; rep_ < ((PROBE_DOUBLE & 1024) ? 2 : 1); ++rep_)
        if (IN(pb + 9)) { CTX(); pg8::Gemm g{(const bf16*)(ws + WS_HN8), (const bf16*)(ws + WS_W + W8_SQKV + (size_t)lp * NQKV_S * DM), MTOK, NQKV_S, DM / 2}; pg8::StaticOrderT<NQKV_S / 256> S; S.init(MTOK,  NQKV_S, F.G, F.bx, F.wave);
            pg8::EpiStore<true, 1> E{(bf16*)(ws + WS_BIG), NQKV_S, (const float*)(ws + WS_SAHN), (const float*)(ws + WS_CMAX) + C_SQKV + lp * NQKV_S, 0.125f * 1.4426950408889634f};
            pg8::gemm_phase<pg8::EpiStore<true, 1>, decltype(S), PG8_ALIGN_EPI, true>(ring, g, S, E); }
        SEAM(pb + 9);
        for (int rep_ = 0; rep_ < ((PROBE_DOUBLE & 16) ? 2 : 1); ++rep_)
        if (IN(pb + 10)) { CTX(); att::sb_phase2((const bf16*)(ws + WS_BIG), (bf16*)(ws + WS_Y), ring, F.vcu, F.G, F.tid, F.wave, F.lane); }
        SEAM(pb + 10);
        if (IN(pb + 11)) { CTX(); pg8::Gemm g{(const bf16*)(ws + WS_Y), WPTR(W_SOUT) + (size_t)lp * DM * DM, MTOK, DM, DM}; pg8::StaticOrderT<DM / 256> S; S.init(MTOK,  DM, F.G, F.bx, F.wave); pg8::EpiResid<false> E{(bf16*)(ws + WS_H), DM, nullptr, nullptr};
            pg8::gemm_phase<pg8::EpiResid<false>, decltype(S), PG8_ALIGN_EPI, true>(ring, g, S, E); }
        SEAM(pb + 11);
        for (int rep_ = 0; rep_ < ((PROBE_DOUBLE & 32) ? 2 : 1); ++rep_)
        if (IN(pb + 12)) { CTX(); router_part1(F, (const bf16*)(ws + WS_H), ws + WS_HN8, (float*)(ws + WS_SAHN), ka->ffn_norm + (size_t)(2 * lp + 1) * DM, ka->moe_router + (size_t)lp * DM * NEXP,
                                               (int*)(ws + WS_RE), (float*)(ws + WS_RW1), (float*)(ws + WS_RW2), (int*)(ws + WS_CNT)); }
        SEAM(pb + 12);
        for (int rep_ = 0; rep_ < ((PROBE_DOUBLE & 32) ? 2 : 1); ++rep_)
        if (IN(pb + 13)) { CTX(); router_part2(F, ws + WS_HN8, (const float*)(ws + WS_SAHN), ws + WS_S + S_HNS, (float*)(ws + WS_SAHNS), (const int*)(ws + WS_RE), (const float*)(ws + WS_RW1), (const float*)(ws + WS_RW2), (const int*)(ws + WS_CNT),
                                               (int*)(ws + WS_POS1), (int*)(ws + WS_POS2), (float*)(ws + WS_GATE), (unsigned*)(ws + WS_PTAB)); }
        SEAM(pb + 13);
        for (int rep_ = 0; rep_ < ((PROBE_DOUBLE & 256) ? 2 : 1); ++rep_)
        if (IN(pb + 14)) { CTX(); unsigned* ptab = (unsigned*)(ws + WS_PTAB); const int npan = (int)__builtin_amdgcn_readfirstlane(__hip_atomic_load(ptab, __ATOMIC_RELAXED, __HIP_MEMORY_SCOPE_AGENT));
            pg8::Gemm g{(const bf16*)(ws + WS_S + S_HNS), (const bf16*)(ws + WS_W + W8_MGU + (size_t)lp * NEXP * NGU * DM), npan * 256, NGU, DM / 2}; pg8::StaticOrderT<NGU / 256> S; S.init(npan * 256,  NGU, F.G, F.bx, F.wave, ptab + 64);
            pg8::EpiSwiGLU<true> E{(bf16*)(ws + WS_BIG), FF, (const float*)(ws + WS_SAHNS), (const float*)(ws + WS_CMAX) + C_MGU + lp * NEXP * NGU};
            pg8::gemm_phase<pg8::EpiSwiGLU<true>, decltype(S), PG8_ALIGN_EPI, true>(ring, g, S, E); }
        SEAM(pb + 14);
        for (int rep_ = 0; rep_ < ((PROBE_DOUBLE & 512) ? 2 : 1); ++rep_)
        if (IN(pb + 15)) { CTX(); unsigned* ptab = (unsigned*)(ws + WS_PTAB); const int npan = (int)__builtin_amdgcn_readfirstlane(__hip_atomic_load(ptab, __ATOMIC_RELAXED, __HIP_MEMORY_SCOPE_AGENT));
            pg8::Gemm g{(const bf16*)(ws + WS_BIG), WPTR(W_MDN) + (size_t)lp * NEXP * DM * FF, npan * 256, DM, FF}; pg8::StaticOrderT<DM / 256> S; S.init(npan * 256,  DM, F.G, F.bx, F.wave, ptab + 64); pg8::EpiMoeDown E{(bf16*)(ws + WS_S + S_YS), DM, (const float*)(ws + WS_GATE)};
            pg8::gemm_phase<pg8::EpiMoeDown, decltype(S), PG8_ALIGN_EPI, true>(ring, g, S, E); }
        SEAM(pb + 15);
    }
    if (IN(34)) { CTX(); norm_rows<3>(F, nullptr, (bf16*)(ws + WS_H), nullptr, nullptr, ka->out, ka->final_norm, (const bf16*)(ws + WS_S + S_YS), (const int*)(ws + WS_POS1), (const int*)(ws + WS_POS2)); }
#undef IN
#undef SEAM
#undef CTX
}

#ifndef MK_SINGLE
#define MK_SINGLE 1
#endif
extern "C" void kernel_launch(void* const* d_in, const int* in_sizes, int n_in, void* d_out, int out_size, void* d_ws, size_t ws_size, hipStream_t stream) {
    static int grid = 0;
    if (grid == 0) {
        if (n_in != 13 || in_sizes[0] != MTOK * DM || out_size != MTOK * DM || ws_size < WS_END) { fprintf(stderr, "kernel_launch: unexpected shapes / workspace (n_in %d, ws %zu)\n", n_in, ws_size); grid = -1; return; }
        int dev = 0, cus = 0, per_cu = 0;
        if (hipGetDevice(&dev) != hipSuccess || hipDeviceGetAttribute(&cus, hipDeviceAttributeMultiprocessorCount, dev) != hipSuccess) { grid = -1; return; }
        if (hipFuncSetAttribute((const void*)mk_fwd, hipFuncAttributeMaxDynamicSharedMemorySize, LDS_BYTES) != hipSuccess) { grid = -1; return; }
        if (hipOccupancyMaxActiveBlocksPerMultiprocessor(&per_cu, (const void*)mk_fwd, NWAVES * 64, LDS_BYTES) != hipSuccess || per_cu < 1) { fprintf(stderr, "kernel_launch: the occupancy query admits %d workgroups of this kernel per CU: the grid barrier needs one resident workgroup per CU; nothing launched\n", per_cu); (void)hipGetLastError(); grid = -1; return; }
        (void)hipGetLastError();
        grid = cus;
    }
    if (grid < 0) return;
    if (hipMemsetAsync((char*)d_ws + WS_CTL, 0, CTL_ZERO_BYTES, stream) != hipSuccess) return;
    Args a{};
    a.x = (const float*)d_in[0]; a.mix_norm = (const float*)d_in[1]; a.ffn_norm = (const float*)d_in[2]; a.dil_w_in = (const float*)d_in[3]; a.dil_w_out = (const float*)d_in[4];
    a.sb_w_qkv = (const float*)d_in[5]; a.sb_w_out = (const float*)d_in[6]; a.ffn_gu = (const float*)d_in[7]; a.ffn_dn = (const float*)d_in[8]; a.moe_router = (const float*)d_in[9];
    a.moe_gu = (const float*)d_in[10]; a.moe_dn = (const float*)d_in[11]; a.final_norm = (const float*)d_in[12]; a.out = (float*)d_out; a.ws = (unsigned char*)d_ws; a.pad = 0;
#if MK_SINGLE
    a.lo = 0; a.hi = N_PHASES; a.li = 0;
    hipLaunchKernelGGL(mk_fwd, dim3(grid), dim3(NWAVES * 64), LDS_BYTES, stream, a);
#else
    for (int ph = 0; ph < N_PHASES; ++ph) { a.lo = ph; a.hi = ph + 1; a.li = 0; hipLaunchKernelGGL(mk_fwd, dim3(grid), dim3(NWAVES * 64), LDS_BYTES, stream, a); }
#endif
}
```
